# Optimizing an MI355X kernel written in HIP

```python
import math
import jax, jax.numpy as jnp
from jax import lax
import numpy as np

D_MODEL = 1024
BATCH = 32
SEQ = 2048
DEPTH = 1
DEC_BATCH = 16
DEC_SEQ = 16
PAST_LEN = 1024

CHUNK = 64
N_META = 16
Q_BLOCK = 128
EPS = 1e-6
NEG = -1e30
FOX_HEADS = 8
FOX_HEAD_DIM = 64
FOX_W = FOX_HEADS * FOX_HEAD_DIM
FOX_SCALE = 1.0 / math.sqrt(FOX_HEAD_DIM)
MLA_HEADS = 8
MLA_NOPE = 64
MLA_ROPE = 32
MLA_V = 64
MLA_QK = MLA_NOPE + MLA_ROPE
MLA_Q_LORA = 384
MLA_KV_LORA = 256
MLA_SCALE = 1.0 / math.sqrt(MLA_QK)
ROPE_BASE = 10000.0
D_FF = 2816
CONV_W = 3
OFF_FK = FOX_W
OFF_FV = 2 * FOX_W
OFF_FF = 3 * FOX_W
OFF_CQ = OFF_FF + FOX_HEADS
OFF_CKV = OFF_CQ + MLA_Q_LORA
OFF_KR = OFF_CKV + MLA_KV_LORA
OFF_GATE = OFF_KR + MLA_ROPE
IN_WIDTH = OFF_GATE + 2 * D_MODEL

kernel_name = 'fox_mla_gated_hybrid_stream_step'


def rmsnorm(x, g):
    xf = x.astype(jnp.float32)
    y = xf * lax.rsqrt(jnp.mean(xf * xf, axis=-1, keepdims=True) + EPS)
    return (y * g.astype(jnp.float32)).astype(x.dtype)


def rope_tables(pos, dtype):
    inv = ROPE_BASE ** (-jnp.arange(0, MLA_ROPE, 2, dtype=jnp.float32) / MLA_ROPE)
    ang = pos.astype(jnp.float32)[:, None] * inv[None, :]
    return jnp.cos(ang).astype(dtype), jnp.sin(ang).astype(dtype)


def apply_rope(x, cos, sin):
    x1, x2 = jnp.split(x, 2, axis=-1)
    return jnp.concatenate([x1 * cos - x2 * sin, x1 * sin + x2 * cos], axis=-1)


def mixer_inputs(xn, pos, lw):
    B, S, _ = xn.shape
    proj = xn @ lw['w_in']
    fq, fk, fv, ff, cq, ckv, kr, gl = jnp.split(
        proj, [OFF_FK, OFF_FV, OFF_FF, OFF_CQ, OFF_CKV, OFF_KR, OFF_GATE], axis=-1)
    fox_q = fq.reshape(B, S, FOX_HEADS, FOX_HEAD_DIM)
    fox_k = fk.reshape(B, S, FOX_HEADS, FOX_HEAD_DIM)
    fox_v = fv.reshape(B, S, FOX_HEADS, FOX_HEAD_DIM)
    fox_logf = jax.nn.log_sigmoid(ff.astype(jnp.float32) + lw['b_forget'].astype(jnp.float32))
    cos, sin = rope_tables(pos, xn.dtype)
    q = (rmsnorm(cq, lw['mla_q_norm_g']) @ lw['w_uq']).reshape(B, S, MLA_HEADS, MLA_QK)
    q_nope, q_rope = jnp.split(q, [MLA_NOPE], axis=-1)
    mla_q = jnp.concatenate([q_nope, apply_rope(q_rope, cos[:, None, :], sin[:, None, :])], axis=-1)
    ckv_n = rmsnorm(ckv, lw['mla_kv_norm_g'])
    k_rope = apply_rope(kr, cos, sin)
    gate_a, gate_b = jnp.split(jax.nn.sigmoid(gl), 2, axis=-1)
    return fox_q, fox_k, fox_v, fox_logf, mla_q, ckv_n, k_rope, gate_a, gate_b


def mla_keys_values(ckv_n, k_rope, w_ukv):
    B, S, _ = ckv_n.shape
    kv = (ckv_n @ w_ukv).reshape(B, S, MLA_HEADS, MLA_NOPE + MLA_V)
    k_nope, v = jnp.split(kv, [MLA_NOPE], axis=-1)
    k_pe = jnp.broadcast_to(k_rope[:, :, None, :], (B, S, MLA_HEADS, MLA_ROPE))
    return jnp.concatenate([k_nope, k_pe], axis=-1), v


def attend(q, k, v, bias, scale):
    s = jnp.einsum('bqhd,bkhd->bhqk', q, k).astype(jnp.float32) * scale + bias
    p = jax.nn.softmax(s, axis=-1).astype(v.dtype)
    return jnp.einsum('bhqk,bkhd->bqhd', p, v)


def sweep_query_blocks(q, k, v, bias_for_block, scale):
    B, Lp, H, _ = q.shape
    starts = jnp.arange(Lp // Q_BLOCK) * Q_BLOCK

    def one(start):
        qb = lax.dynamic_slice_in_dim(q, start, Q_BLOCK, axis=1)
        return attend(qb, k, v, bias_for_block(start), scale)

    out = lax.map(one, starts)
    return jnp.moveaxis(out, 0, 1).reshape(B, Lp, H, v.shape[-1])


def merge_branches(o_fox, o_mla, gate_a, gate_b, lw):
    B, S = o_fox.shape[:2]
    ya = o_fox.reshape(B, S, FOX_W) @ lw['w_o_fox']
    yb = o_mla.reshape(B, S, MLA_HEADS * MLA_V) @ lw['w_o_mla']
    return (gate_a * ya + gate_b * yb) @ lw['w_out']


def conv_ffn(xn, left, lw):
    u = xn @ lw['w_up']
    S = u.shape[1]
    up = jnp.concatenate([left.astype(u.dtype), u], axis=1)
    c = lw['conv_b']
    for j in range(CONV_W):
        c = c + up[:, j:j + S] * lw['conv_w'][j]
    gate, val = jnp.split(c, 2, axis=-1)
    return (jax.nn.silu(gate) * val) @ lw['w_down'], up[:, up.shape[1] - (CONV_W - 1):]


def prompt_layer(h, lw):
    B, L, _ = h.shape
    Lp = -(-L // Q_BLOCK) * Q_BLOCK
    pad = Lp - L
    xn = rmsnorm(h, lw['norm_mix_g'])
    fq, fk, fv, flogf, mq, ckv_n, k_rope, ga, gb = mixer_inputs(xn, jnp.arange(L), lw)
    padseq = lambda a: jnp.pad(a, [(0, 0), (0, pad)] + [(0, 0)] * (a.ndim - 2))
    idx = jnp.arange(Lp)
    F = jnp.swapaxes(jnp.cumsum(padseq(flogf), axis=1), 1, 2)

    def fox_bias(start):
        tq = start + jnp.arange(Q_BLOCK)
        Fq = lax.dynamic_slice_in_dim(F, start, Q_BLOCK, axis=2)
        causal = (idx[None, :] <= tq[:, None])[None, None]
        return jnp.where(causal, Fq[..., None] - F[:, :, None, :], NEG)

    o_fox = sweep_query_blocks(padseq(fq), padseq(fk), padseq(fv), fox_bias, FOX_SCALE)[:, :L]
    k_mla, v_mla = mla_keys_values(ckv_n, k_rope, lw['w_ukv'])
    cid = jnp.where(idx < N_META, 0, 1 + (idx - N_META) // CHUNK)
    key_ok = idx < L

    def mla_bias(start):
        cq = lax.dynamic_slice_in_dim(cid, start, Q_BLOCK)
        ok = (cid[None, :] <= cq[:, None]) & key_ok[None, :]
        return jnp.where(ok, 0.0, NEG)[None, None]

    o_mla = sweep_query_blocks(padseq(mq), padseq(k_mla), padseq(v_mla), mla_bias, MLA_SCALE)[:, :L]
    h = h + merge_branches(o_fox, o_mla, ga, gb, lw)
    left = jnp.zeros((B, CONV_W - 1, 2 * D_FF), h.dtype)
    f, conv_state = conv_ffn(rmsnorm(h, lw['norm_ffn_g']), left, lw)
    h = h + f
    return h, (fk, fv, flogf, ckv_n, k_rope, conv_state)


def sample_layer(h, ck, cv, clogf, cckv, ckr, cconv, lw):
    B, n, _ = h.shape
    P = ck.shape[1]
    xn = rmsnorm(h, lw['norm_mix_g'])
    fq, fk, fv, flogf, mq, ckv_n, k_rope, ga, gb = mixer_inputs(xn, P + jnp.arange(n), lw)
    k_all = jnp.concatenate([ck.astype(fk.dtype), fk], axis=1)
    v_all = jnp.concatenate([cv.astype(fv.dtype), fv], axis=1)
    F = jnp.swapaxes(jnp.cumsum(jnp.concatenate([clogf.astype(jnp.float32), flogf], axis=1), axis=1), 1, 2)
    j = jnp.arange(P + n)
    t = P + jnp.arange(n)
    causal = (j[None, :] <= t[:, None])[None, None]
    fox_bias = jnp.where(causal, F[:, :, P:, None] - F[:, :, None, :], NEG)
    o_fox = attend(fq, k_all, v_all, fox_bias, FOX_SCALE)
    ckv_all = jnp.concatenate([cckv.astype(ckv_n.dtype), ckv_n], axis=1)
    kr_all = jnp.concatenate([ckr.astype(k_rope.dtype), k_rope], axis=1)
    k_mla, v_mla = mla_keys_values(ckv_all, kr_all, lw['w_ukv'])
    o_mla = attend(mq, k_mla, v_mla, 0.0, MLA_SCALE)
    h = h + merge_branches(o_fox, o_mla, ga, gb, lw)
    f, conv_state = conv_ffn(rmsnorm(h, lw['norm_ffn_g']), cconv, lw)
    h = h + f
    return h, (fk, fv, flogf, ckv_n, k_rope, conv_state)


def setup_inputs(seed: int = 0) -> dict:
    key = jax.random.key(seed)
    ks = jax.random.split(key, 32)
    nrm = lambda k, shape, s=1.0: jax.random.normal(k, shape, jnp.float32) * s
    gain = lambda k, shape: 1.0 + 0.1 * jax.random.normal(k, shape, jnp.float32)
    return {
        'x_prompt': nrm(ks[0], (BATCH, SEQ, D_MODEL)),
        'x_sample': nrm(ks[1], (DEC_BATCH, DEC_SEQ, D_MODEL)),
        'cache_fox_k': nrm(ks[2], (DEPTH, DEC_BATCH, PAST_LEN, FOX_HEADS, FOX_HEAD_DIM)),
        'cache_fox_v': nrm(ks[3], (DEPTH, DEC_BATCH, PAST_LEN, FOX_HEADS, FOX_HEAD_DIM)),
        'cache_fox_logf': jax.nn.log_sigmoid(4.0 + nrm(ks[4], (DEPTH, DEC_BATCH, PAST_LEN, FOX_HEADS))),
        'cache_mla_ckv': nrm(ks[5], (DEPTH, DEC_BATCH, PAST_LEN, MLA_KV_LORA)),
        'cache_mla_krope': nrm(ks[6], (DEPTH, DEC_BATCH, PAST_LEN, MLA_ROPE)),
        'state_ffn_conv': nrm(ks[7], (DEPTH, DEC_BATCH, CONV_W - 1, 2 * D_FF)),
        'meta_tokens': nrm(ks[8], (N_META, D_MODEL)),
        'norm_mix_g': gain(ks[9], (DEPTH, D_MODEL)),
        'w_in': nrm(ks[10], (DEPTH, D_MODEL, IN_WIDTH), D_MODEL ** -0.5),
        'b_forget': 4.0 + nrm(ks[11], (DEPTH, FOX_HEADS)),
        'mla_q_norm_g': gain(ks[12], (DEPTH, MLA_Q_LORA)),
        'w_uq': nrm(ks[13], (DEPTH, MLA_Q_LORA, MLA_HEADS * MLA_QK), MLA_Q_LORA ** -0.5),
        'mla_kv_norm_g': gain(ks[14], (DEPTH, MLA_KV_LORA)),
        'w_ukv': nrm(ks[15], (DEPTH, MLA_KV_LORA, MLA_HEADS * (MLA_NOPE + MLA_V)), MLA_KV_LORA ** -0.5),
        'w_o_fox': nrm(ks[16], (DEPTH, FOX_W, D_MODEL), FOX_W ** -0.5),
        'w_o_mla': nrm(ks[17], (DEPTH, MLA_HEADS * MLA_V, D_MODEL), (MLA_HEADS * MLA_V) ** -0.5),
        'w_out': nrm(ks[18], (DEPTH, D_MODEL, D_MODEL), D_MODEL ** -0.5),
        'norm_ffn_g': gain(ks[19], (DEPTH, D_MODEL)),
        'w_up': nrm(ks[20], (DEPTH, D_MODEL, 2 * D_FF), D_MODEL ** -0.5),
        'conv_w': nrm(ks[21], (DEPTH, CONV_W, 2 * D_FF), CONV_W ** -0.5),
        'conv_b': nrm(ks[22], (DEPTH, 2 * D_FF), 0.02),
        'w_down': nrm(ks[23], (DEPTH, D_FF, D_MODEL), D_FF ** -0.5),
        'norm_final_g': gain(ks[24], (D_MODEL,)),
    }


def reference(x_prompt, x_sample, cache_fox_k, cache_fox_v, cache_fox_logf, cache_mla_ckv, cache_mla_krope,
              state_ffn_conv, meta_tokens, norm_mix_g, w_in, b_forget, mla_q_norm_g, w_uq, mla_kv_norm_g, w_ukv,
              w_o_fox, w_o_mla, w_out, norm_ffn_g, w_up, conv_w, conv_b, w_down, norm_final_g):
    B = x_prompt.shape[0]
    meta = jnp.broadcast_to(meta_tokens[None].astype(x_prompt.dtype), (B, N_META, D_MODEL))
    h_p = jnp.concatenate([meta, x_prompt], axis=1)
    h_s = x_sample
    new_p = []
    new_s = []
    for layer in range(DEPTH):
        lw = {
            'norm_mix_g': norm_mix_g[layer], 'w_in': w_in[layer], 'b_forget': b_forget[layer],
            'mla_q_norm_g': mla_q_norm_g[layer], 'w_uq': w_uq[layer], 'mla_kv_norm_g': mla_kv_norm_g[layer],
            'w_ukv': w_ukv[layer], 'w_o_fox': w_o_fox[layer], 'w_o_mla': w_o_mla[layer], 'w_out': w_out[layer],
            'norm_ffn_g': norm_ffn_g[layer], 'w_up': w_up[layer], 'conv_w': conv_w[layer],
            'conv_b': conv_b[layer], 'w_down': w_down[layer],
        }
        h_p, st_p = prompt_layer(h_p, lw)
        h_s, st_s = sample_layer(h_s, cache_fox_k[layer], cache_fox_v[layer], cache_fox_logf[layer],
                                 cache_mla_ckv[layer], cache_mla_krope[layer], state_ffn_conv[layer], lw)
        new_p.append(st_p)
        new_s.append(st_s)
    stk = lambda states, i: jnp.stack([s[i] for s in states], axis=0)
    y_prompt = rmsnorm(h_p, norm_final_g)[:, N_META:]
    y_sample = rmsnorm(h_s, norm_final_g)
    return (y_prompt, y_sample,
            stk(new_p, 0), stk(new_p, 1), stk(new_p, 2), stk(new_p, 3), stk(new_p, 4), stk(new_p, 5),
            stk(new_s, 0), stk(new_s, 1), stk(new_s, 2), stk(new_s, 3), stk(new_s, 4), stk(new_s, 5))
```

```cpp
#include <hip/hip_runtime.h>
#include <hip/hip_cooperative_groups.h>
#include <cstdio>
#include <cstdint>
namespace cg = cooperative_groups;

constexpr int D = 1024, NB = 32, SEQ = 2048, NMETA = 16, LSEQ = 2064, PADR = 48, LP = 2112;
constexpr int MP = NB * LP;
constexpr int SB = 16, SN = 16, PAST = 1024, MS = SB * SN;
constexpr int MT = MP + MS;
constexpr int MTA = MT + 256;
constexpr int SXR = 1088;
constexpr int ER = MP + SB * SXR;
constexpr int NH = 8, INW = 4264, INWP = 4352, DFF = 2816, UPW = 5632;
constexpr int OFF_FF = 1536, OFF_CQ = 1544, OFF_CKV = 1928, OFF_KR = 2184, OFF_GATE = 2216;
constexpr float EPS = 1e-6f, LOG2E = 1.4426950408889634f;
constexpr size_t O_YP = 0, O_YS = O_YP + (size_t)NB * SEQ * D, O_KP = O_YS + (size_t)MS * D, O_VP = O_KP + (size_t)NB * LSEQ * 512, O_LFP = O_VP + (size_t)NB * LSEQ * 512,
                 O_CKVP = O_LFP + (size_t)NB * LSEQ * 8, O_KRP = O_CKVP + (size_t)NB * LSEQ * 256, O_CVP = O_KRP + (size_t)NB * LSEQ * 32, O_KS = O_CVP + (size_t)NB * 2 * UPW,
                 O_VS = O_KS + (size_t)MS * 512, O_LFS = O_VS + (size_t)MS * 512, O_CKVS = O_LFS + (size_t)MS * 8, O_KRS = O_CKVS + (size_t)MS * 256, O_CVS = O_KRS + (size_t)MS * 32,
                 O_END = O_CVS + (size_t)SB * 2 * UPW;
constexpr size_t AL(size_t x) { return (x + 4095) & ~(size_t)4095; }
constexpr size_t W_WIN = 0, W_WUQ = AL(W_WIN + (size_t)INWP * D * 2), W_WUKV = AL(W_WUQ + (size_t)768 * 384 * 2), W_WOF = AL(W_WUKV + (size_t)1024 * 256 * 2), W_WOM = AL(W_WOF + (size_t)1024 * 512 * 2),
                 W_WOUT = AL(W_WOM + (size_t)1024 * 512 * 2), W_WUP = AL(W_WOUT + (size_t)D * D * 2), W_WDN = AL(W_WUP + (size_t)UPW * D * 2), W_ROPE = AL(W_WDN + (size_t)D * DFF * 2),
                 W_SS2 = AL(W_ROPE + (size_t)LSEQ * 16 * 8), W_SS3 = AL(W_SS2 + (size_t)MT * 4), W_XN = AL(W_SS3 + (size_t)MT * 4),
                 W_FQ = AL(W_XN + (size_t)MTA * D * 2), W_FK = AL(W_FQ + (size_t)MTA * 512 * 2), W_FV = AL(W_FK + (size_t)ER * 512 * 2), W_MISC = AL(W_FV + (size_t)ER * 512 * 2),
                 W_GATES = AL(W_MISC + (size_t)MT * 768 * 4), W_END = AL(W_GATES + (size_t)MT * 2048 * 2);
constexpr size_t W_CQ = W_XN, W_CKVN = AL(W_CQ + (size_t)MT * 384 * 2), W_KR = AL(W_CKVN + (size_t)ER * 256 * 2), W_LOGF = AL(W_KR + (size_t)ER * 32 * 2), W_FB = AL(W_LOGF + (size_t)ER * 8 * 4),
                 W_XN_END = AL(W_FB + (size_t)ER * 8 * 4);
static_assert(W_XN_END <= W_FQ, "XN-region overlay");
constexpr size_t W_MIX = W_XN;
constexpr size_t W_QMLA = W_MISC, W_OM = AL(W_QMLA + (size_t)MTA * 768 * 2);
static_assert(W_OM + (size_t)MTA * 512 * 2 <= W_GATES, "MISC-region overlay");
constexpr size_t W_H1 = W_GATES, W_H1B = W_MISC, W_G = W_XN;
static_assert(W_G + (size_t)MT * DFF * 2 <= W_MISC, "G overlay");
static_assert((size_t)ER * 1024 * 2 <= (size_t)NB * SEQ * D * 4, "KVMLA lives in the y_prompt region of d_out until the last phase");

#define GAS __attribute__((address_space(1)))
#define LAS __attribute__((address_space(3)))
typedef unsigned short bf16;
typedef unsigned u32x4 __attribute__((ext_vector_type(4)));
typedef unsigned u32x2 __attribute__((ext_vector_type(2)));
typedef float f32x4 __attribute__((ext_vector_type(4)));
typedef float f32x2v __attribute__((ext_vector_type(2)));
typedef float f32x16 __attribute__((ext_vector_type(16)));
typedef short bf16x8 __attribute__((ext_vector_type(8)));
typedef short s16x4 __attribute__((ext_vector_type(4)));
typedef __bf16 bf16x2_t __attribute__((ext_vector_type(2)));
#define LDS_WAIT() asm volatile("s_waitcnt lgkmcnt(0)" ::: "memory")
__device__ __forceinline__ unsigned pk2(float lo, float hi) { f32x2v v = {lo, hi}; bf16x2_t b = __builtin_convertvector(v, bf16x2_t); return __builtin_bit_cast(unsigned, b); }
__device__ __forceinline__ float bflo(unsigned w) { return __uint_as_float(w << 16); }
__device__ __forceinline__ float bfhi(unsigned w) { return __uint_as_float(w & 0xffff0000u); }
__device__ __forceinline__ u32x4 pk8(f32x4 a, f32x4 b) { u32x4 w; w.x = pk2(a[0], a[1]); w.y = pk2(a[2], a[3]); w.z = pk2(b[0], b[1]); w.w = pk2(b[2], b[3]); return w; }
__device__ __forceinline__ float wave_sum(float v) {
#pragma unroll
    for (int o = 1; o < 64; o <<= 1) v += __shfl_xor(v, o);
    return v;
}
__device__ __forceinline__ int ext_row(int m) { return m < MP ? m : MP + ((m - MP) >> 4) * SXR + PAST + ((m - MP) & 15); }
__device__ __forceinline__ int out_row(int m) {
    if (m >= MP) return m < MT ? -1 - (m - MP) : (int)0x80000000;
    const int b = m / LP, tp = m - b * LP;
    return tp >= PADR ? b * LSEQ + (tp - PADR) : (int)0x80000000;
}
__device__ __forceinline__ int pos_of(int m) { if (m >= MP) return PAST + ((m - MP) & 15); const int tp = m % LP; return tp >= PADR ? tp - PADR : 0; }
struct KArgs { const float* in[25]; float* out; unsigned char* ws; };

namespace pg8 {
#define PG8_LAS __attribute__((address_space(3)))
typedef unsigned short bf16_t;
typedef short bf16x8 __attribute__((ext_vector_type(8)));
typedef float f32x4 __attribute__((ext_vector_type(4)));
typedef unsigned u32x4 __attribute__((ext_vector_type(4)));
constexpr int BM = 256, BK = 64, HALF = 128, HTB = HALF * BK * 2  , STAGE_BYTES = 8 * HTB, NXCD = 8, WGM = 8;

__host__ __device__ __forceinline__ int lds_byte(int r, int c) { const int st = (r >> 4) * 2 + (c >> 5), rr = r & 15, cc = c & 31, ob = rr * 64 + cc * 2; return st * 1024 + (ob ^ (((ob >> 9) & 1) << 5)); }
__host__ __device__ __forceinline__ void stage_rc(int b, int& R, int& C) { const int st = b / 1024, sb = b % 1024, swz = sb ^ (((sb >> 9) & 1) << 5); R = (st >> 1) * 16 + swz / 64; C = (st & 1) * 32 + (swz % 64) / 2; }
__host__ __device__ __forceinline__ int perm32(int rho) { const int n = rho >> 4, i = rho & 15; return 8 * (i >> 2) + 4 * n + (i & 3); }

struct Unit { int pm, pn; };
struct Gemm { const bf16_t* A; const bf16_t* Bt; int M, N, K; };

struct StaticOrder {
    int nM, nN, nwg, G, c;
    __host__ __device__ void init(int M, int N, int G_, int c_) { nM = M / BM; nN = N / BM; nwg = nM * nN; G = G_; c = c_; }
    __host__ __device__ bool next(int i, Unit& u) const {
        const long L = (long)i * G + c; if (L >= nwg) return false;
        int wgid = (int)L; { const int q = nwg / NXCD, r = nwg % NXCD, xcd = wgid % NXCD, off = wgid / NXCD; wgid = (xcd < r ? xcd * (q + 1) : r * (q + 1) + (xcd - r) * q) + off; }
        const int nig = WGM * nN, gid = wgid / nig, fm = gid * WGM, gsz = (nM - fm) < WGM ? (nM - fm) : WGM;
        u.pm = fm + ((wgid % nig) % gsz); u.pn = (wgid % nig) / gsz; return true;
    }
    __device__ __forceinline__ void a_ready(const Unit&) const {}
    __device__ __forceinline__ void done(const Unit&) const {}
};


struct AMap { int perm, wrs, trows; };
#define PG8_ROW(ai, m) (u.pm * BM + (ai) * HALF + wr * 64 + (m) * 16 + fr)
#define PG8_EACH_AM _Pragma("unroll") for (int ai = 0; ai < 2; ++ai) _Pragma("unroll") for (int m = 0; m < 4; ++m)
#define PG8_RELANE do { int t_ = threadIdx.x; asm volatile("" : "+v"(t_)); fr = t_ & 15; fq = (t_ >> 4) & 3; const int w_ = __builtin_amdgcn_readfirstlane(t_ >> 6); wr = w_ >> 2; wc = w_ & 3; } while (0)
#define PG8_EACH_BJ _Pragma("unroll") for (int bj = 0; bj < 2; ++bj)
__device__ __forceinline__ f32x4 sig4(f32x4 x) { f32x4 r;
#pragma unroll
    for (int i = 0; i < 4; ++i) r[i] = __builtin_amdgcn_rcpf(1.f + __expf(-x[i])); return r; }
__device__ __forceinline__ f32x4 unlo(u32x2 w) { return (f32x4){::bflo(w.x), ::bfhi(w.x), ::bflo(w.y), ::bfhi(w.y)}; }
__device__ __forceinline__ float dpp_shr1(float v) { return __builtin_bit_cast(float, __builtin_amdgcn_update_dpp(0, __builtin_bit_cast(int, v), 0x111, 0xF, 0xF, false)); }

struct EpiPlain {
    static constexpr bool PERM = true, AFTER_DRAIN = false;
    bf16_t* O; int ldc;
    __device__ __forceinline__ void operator()(const f32x4 (&acc)[2][2][4][2], const Unit& u, int wr, int wc, int fr, int fq) const { PG8_RELANE;
        const int colb = u.pn * BM + wc * 32 + 8 * fq;
        PG8_EACH_AM { bf16_t* p = O + (size_t)PG8_ROW(ai, m) * ldc + colb;
            PG8_EACH_BJ *(u32x4*)(p + bj * HALF) = ::pk8(acc[ai][bj][m][0], acc[ai][bj][m][1]); }
    }
};
struct EpiWin {
    static constexpr bool PERM = true, AFTER_DRAIN = false;
    bf16_t *FQ, *FK, *FV, *GATES; float* MISC; float* out;
    __device__ __forceinline__ void operator()(const f32x4 (&acc)[2][2][4][2], const Unit& u, int wr, int wc, int fr, int fq) const { PG8_RELANE;
        const int pn = u.pn, cw = wc * 32 + 8 * fq;
        PG8_EACH_AM { const int row = PG8_ROW(ai, m);
            if (pn < 2) { bf16_t* p = FQ + (size_t)row * 512 + pn * 256 + cw;
                PG8_EACH_BJ *(u32x4*)(p + bj * HALF) = ::pk8(acc[ai][bj][m][0], acc[ai][bj][m][1]); }
            else if (pn < 6) { const int which = (pn - 2) >> 1, c = ((pn - 2) & 1) * 256 + cw; const int er = ::ext_row(row), orow = ::out_row(row);
                bf16_t* p = (which ? FV : FK) + (size_t)er * 512 + c; float* o = nullptr;
                if (orow >= 0) o = out + (which ? O_VP : O_KP) + (size_t)orow * 512 + c; else if (orow != (int)0x80000000) o = out + (which ? O_VS : O_KS) + (size_t)(-1 - orow) * 512 + c;
                PG8_EACH_BJ { *(u32x4*)(p + bj * HALF) = ::pk8(acc[ai][bj][m][0], acc[ai][bj][m][1]);
                    if (o) { *(f32x4*)(o + bj * HALF) = acc[ai][bj][m][0]; *(f32x4*)(o + bj * HALF + 4) = acc[ai][bj][m][1]; } } }
            else if (pn < 9) { float* p = MISC + (size_t)row * 768 + (pn - 6) * 256 + cw;
                PG8_EACH_BJ { *(f32x4*)(p + bj * HALF) = acc[ai][bj][m][0]; *(f32x4*)(p + bj * HALF + 4) = acc[ai][bj][m][1]; } }
            else { bf16_t* p = GATES + (size_t)row * 2048 + (pn - 9) * 256 + cw;
                PG8_EACH_BJ *(u32x4*)(p + bj * HALF) = ::pk8(sig4(acc[ai][bj][m][0]), sig4(acc[ai][bj][m][1])); }
            asm volatile("" ::: "memory");
        }
    }
};
struct EpiQ {
    static constexpr bool PERM = true, AFTER_DRAIN = false;
    bf16_t* Q; const float* rope;
    __device__ __forceinline__ void operator()(const f32x4 (&acc)[2][2][4][2], const Unit& u, int wr, int wc, int fr, int fq) const { PG8_RELANE;
        PG8_EACH_BJ { const int g32 = u.pn * 8 + bj * 4 + wc; const bool rp = (g32 % 3) == 2; const float sg = (fq < 2) ? -1.f : 1.f;
            PG8_EACH_AM { const int row = PG8_ROW(ai, m); f32x4 v0 = acc[ai][bj][m][0], v1 = acc[ai][bj][m][1];
                if (rp) { const float* t = rope + ((size_t)::pos_of(row) * 16 + 8 * (fq & 1)) * 2;
                    const f32x4 t0 = *(const f32x4*)t, t1 = *(const f32x4*)(t + 4), t2 = *(const f32x4*)(t + 8), t3 = *(const f32x4*)(t + 12);
                    f32x4 q0, q1;
#pragma unroll
                    for (int i = 0; i < 4; ++i) { q0[i] = __shfl_xor(v0[i], 32); q1[i] = __shfl_xor(v1[i], 32); }
                    v0[0] = v0[0] * t0[0] + sg * q0[0] * t0[1]; v0[1] = v0[1] * t0[2] + sg * q0[1] * t0[3]; v0[2] = v0[2] * t1[0] + sg * q0[2] * t1[1]; v0[3] = v0[3] * t1[2] + sg * q0[3] * t1[3];
                    v1[0] = v1[0] * t2[0] + sg * q1[0] * t2[1]; v1[1] = v1[1] * t2[2] + sg * q1[1] * t2[3]; v1[2] = v1[2] * t3[0] + sg * q1[2] * t3[1]; v1[3] = v1[3] * t3[2] + sg * q1[3] * t3[3]; }
                *(u32x4*)(Q + (size_t)row * 768 + u.pn * BM + bj * HALF + wc * 32 + 8 * fq) = ::pk8(v0, v1); asm volatile("" ::: "memory"); } }
    }
};
template <int SECOND> struct EpiMix {
    static constexpr bool PERM = true, AFTER_DRAIN = false;
    bf16_t* MIX; const bf16_t* GATES;
    __device__ __forceinline__ void operator()(const f32x4 (&acc)[2][2][4][2], const Unit& u, int wr, int wc, int fr, int fq) const { PG8_RELANE;
        const int colb = u.pn * BM + wc * 32 + 8 * fq;
        PG8_EACH_AM { const int row = PG8_ROW(ai, m);
            PG8_EACH_BJ { const int col = colb + bj * HALF; const u32x4 g = *(const u32x4*)(GATES + (size_t)row * 2048 + SECOND * 1024 + col);
                f32x4 a = acc[ai][bj][m][0] * unlo((u32x2){g.x, g.y}), b = acc[ai][bj][m][1] * unlo((u32x2){g.z, g.w});
                bf16_t* p = MIX + (size_t)row * 1024 + col;
                if (SECOND) { const u32x4 o = *(const u32x4*)p; a += unlo((u32x2){o.x, o.y}); b += unlo((u32x2){o.z, o.w}); }
                *(u32x4*)p = ::pk8(a, b); } }
    }
};
struct EpiH1 {
    static constexpr bool PERM = true, AFTER_DRAIN = false;
    const float *xp, *meta, *xs; float* H1; bf16_t* H1B; float* SS;
    __device__ __forceinline__ void operator()(const f32x4 (&acc)[2][2][4][2], const Unit& u, int wr, int wc, int fr, int fq) const { PG8_RELANE;
        const int colb = u.pn * BM + wc * 32 + 8 * fq;
        PG8_EACH_AM { const int row = PG8_ROW(ai, m); const float* xr = nullptr;
            if (row >= MP) xr = xs + (size_t)(row - MP) * D; else { const int b = row / LP, tp = row - b * LP; if (tp >= 64) xr = xp + ((size_t)b * SEQ + (tp - 64)) * D; else if (tp >= PADR) xr = meta + (size_t)(tp - PADR) * D; }
            float ss = 0.f;
            PG8_EACH_BJ { const int col = colb + bj * HALF; f32x4 a = acc[ai][bj][m][0], b = acc[ai][bj][m][1];
                if (xr) { a += *(const f32x4*)(xr + col); b += *(const f32x4*)(xr + col + 4); }
                *(f32x4*)(H1 + (size_t)row * D + col) = a; *(f32x4*)(H1 + (size_t)row * D + col + 4) = b; *(u32x4*)(H1B + (size_t)row * D + col) = ::pk8(a, b);
                ss += (a[0] * a[0] + a[1] * a[1]) + (a[2] * a[2] + a[3] * a[3]) + (b[0] * b[0] + b[1] * b[1]) + (b[2] * b[2] + b[3] * b[3]); }
            ss += __shfl_xor(ss, 16); ss += __shfl_xor(ss, 32);
            if (fq == 0) unsafeAtomicAdd(SS + row, ss); }
    }
};
struct EpiH2 {
    static constexpr bool PERM = true, AFTER_DRAIN = false;
    float* H1; float* SS;
    __device__ __forceinline__ void operator()(const f32x4 (&acc)[2][2][4][2], const Unit& u, int wr, int wc, int fr, int fq) const { PG8_RELANE;
        const int colb = u.pn * BM + wc * 32 + 8 * fq;
        PG8_EACH_AM { const int row = PG8_ROW(ai, m); float ss = 0.f;
            PG8_EACH_BJ { float* p = H1 + (size_t)row * D + colb + bj * HALF; const f32x4 a = acc[ai][bj][m][0] + *(const f32x4*)p, b = acc[ai][bj][m][1] + *(const f32x4*)(p + 4);
                *(f32x4*)p = a; *(f32x4*)(p + 4) = b;
                ss += (a[0] * a[0] + a[1] * a[1]) + (a[2] * a[2] + a[3] * a[3]) + (b[0] * b[0] + b[1] * b[1]) + (b[2] * b[2] + b[3] * b[3]); }
            ss += __shfl_xor(ss, 16); ss += __shfl_xor(ss, 32);
            if (fq == 0) unsafeAtomicAdd(SS + row, ss); }
    }
};
template <bool SAMPLE> struct EpiConv {
    static constexpr bool PERM = true, AFTER_DRAIN = false;
    bf16_t* G; const float* ss2; const float* convw; const float* convb; const float* state; float* out; int wrs;
    __device__ __forceinline__ void operator()(const f32x4 (&acc)[2][2][4][2], const Unit& u, int wr, int wc, int fr, int fq) const { PG8_RELANE;
        const int base = (SAMPLE ? MP : u.pm * 252) + wrs * wr + 8 * fr;
        float rs[8];
#pragma unroll
        for (int j = 0; j < 8; ++j) { const int tok = base + j;
            if (SAMPLE) rs[j] = __builtin_amdgcn_rsqf(ss2[tok] * (1.f / D) + EPS);
            else { const int tc = tok < MT ? tok : MT - 1; const bool v = tok < MP && (tc % LP) >= PADR; rs[j] = v ? __builtin_amdgcn_rsqf(ss2[tc] * (1.f / D) + EPS) : 0.f; } }
        const int chb = u.pn * 128 + wc * 32 + 8 * fq;
        const int sb = 8 * wr + (fr >> 1);
#pragma unroll
        for (int n = 0; n < 2; ++n) { const int ch = chb + 4 * n; f32x4 cg[8];
#pragma unroll
            for (int bj = 0; bj < 2; ++bj) { const int cx = bj * DFF + ch;
                const f32x4 cb = *(const f32x4*)(convb + cx), w0 = *(const f32x4*)(convw + cx), w1 = *(const f32x4*)(convw + UPW + cx), w2 = *(const f32x4*)(convw + 2 * UPW + cx);
                f32x4 p1, p2;
                { const f32x4 u7 = acc[1][bj][3][n] * rs[7], u6 = acc[1][bj][2][n] * rs[6];
#pragma unroll
                    for (int e = 0; e < 4; ++e) { p1[e] = dpp_shr1(u7[e]); p2[e] = dpp_shr1(u6[e]); } }
                if (SAMPLE) { if (!(fr & 1)) { p1 = *(const f32x4*)(state + ((size_t)sb * 2 + 1) * UPW + cx); p2 = *(const f32x4*)(state + ((size_t)sb * 2) * UPW + cx); } }
                f32x4 um2 = p2, um1 = p1;
#pragma unroll
                for (int j = 0; j < 8; ++j) { const int tok = base + j; const f32x4 uj = acc[j >> 2][bj][j & 3][n] * rs[j];
                    const bool okw = SAMPLE || (tok < MP && (fr > 0 || j >= 2));
                    if (SAMPLE) { if ((fr & 1) && j >= 6) *(f32x4*)(out + O_CVS + ((size_t)sb * 2 + (j - 6)) * UPW + cx) = uj; }
                    else if (okw) { const int b = tok / LP, tp = tok - b * LP; if (tp >= LP - 2) *(f32x4*)(out + O_CVP + ((size_t)b * 2 + (tp - (LP - 2))) * UPW + cx) = uj; }
                    const f32x4 c = cb + w0 * um2 + w1 * um1 + w2 * uj; um2 = um1; um1 = uj;
                    if (bj == 0) cg[j] = c;
                    else { const f32x4 o = cg[j] * sig4(cg[j]) * c;
                        if (okw) *(u32x2*)(G + (size_t)tok * DFF + ch) = (u32x2){::pk2(o[0], o[1]), ::pk2(o[2], o[3])}; asm volatile("" ::: "memory"); } }
                asm volatile("" ::: "memory");
            } }
    }
};
template <class Epi, class Sched, bool ALIGN_EPI = false, bool SP2 = false>
__device__ __forceinline__ void gemm_phase(PG8_LAS unsigned char* lds, const Gemm g, const Sched& S, const Epi& E, const AMap am) {
    int tid_ = threadIdx.x; asm volatile("" : "+v"(tid_));
    const int tid = tid_, wid = __builtin_amdgcn_readfirstlane(tid >> 6), lane = tid & 63, wr = wid >> 2, wc = wid & 3, fr = lane & 15, fq = lane >> 4;
    int K_ = g.K; asm volatile("" : "+s"(K_)); const int K = K_, nt = K / BK;
    unsigned voffA[2], voffB[2];
#pragma unroll
    for (int i = 0; i < 2; ++i) { int R, C; stage_rc(tid * 16 + i * 8192, R, C); const int Rb = Epi::PERM ? ((R & ~31) + perm32(R & 31)) : R;
        voffA[i] = (unsigned)((am.perm ? (am.wrs * (R >> 6) + 8 * (R & 15) + ((R >> 4) & 3)) : R) * K + C) * 2u; voffB[i] = (unsigned)(Rb * K + C) * 2u; }
    const size_t kstep = (size_t)(BK * 2);
    const size_t hstep = (size_t)HALF * K * 2;
    const size_t tstep = 2 * hstep;
    const size_t hstepA = am.perm ? (size_t)4 * K * 2 : hstep; const size_t tstepA = (size_t)am.trows * K * 2;
    const unsigned ldsw = (unsigned)wid * 1024u;
    const int aoff = lds_byte(wr * 64 + fr, fq * 8), boff = lds_byte(wc * 32 + fr, fq * 8);
#define PG8_SA(b, h) (((b) * 2 + (h)) * HTB)
#define PG8_SB(b, h) ((4 + (b) * 2 + (h)) * HTB)
#define PG8_STAGE(bufoff, gbase, voff) do { _Pragma("unroll") for (int _i = 0; _i < 2; ++_i) \
        __builtin_amdgcn_global_load_lds((const unsigned*)((const char*)(gbase) + (voff)[_i]), (PG8_LAS unsigned*)(lds + (bufoff) + ldsw + _i * 8192), 16, 0, 0); } while (0)
#define PG8_LDA(dst, b, h) do { _Pragma("unroll") for (int m = 0; m < 4; ++m) _Pragma("unroll") for (int k = 0; k < 2; ++k) dst[m][k] = *(const PG8_LAS bf16x8*)(lds + PG8_SA(b, h) + aoff + m * 2048 + k * 1024); } while (0)
#define PG8_LDB(dst, b, h) do { _Pragma("unroll") for (int n = 0; n < 2; ++n) _Pragma("unroll") for (int k = 0; k < 2; ++k) dst[n][k] = *(const PG8_LAS bf16x8*)(lds + PG8_SB(b, h) + boff + n * 2048 + k * 1024); } while (0)
#define PG8_MMA(ai, bj, At, Bt) do { __builtin_amdgcn_s_setprio(1); _Pragma("unroll") for (int m = 0; m < 4; ++m) _Pragma("unroll") for (int n = 0; n < 2; ++n) _Pragma("unroll") for (int k = 0; k < 2; ++k) \
        acc[ai][bj][m][n] = __builtin_amdgcn_mfma_f32_16x16x32_bf16(Bt[n][k], At[m][k], acc[ai][bj][m][n], 0, 0, 0); __builtin_amdgcn_s_setprio(0); } while (0)
#define PG8_WAIT_V(n) asm volatile("s_waitcnt vmcnt(" #n ")" ::: "memory")
#define PG8_WAIT_L(n) asm volatile("s_waitcnt lgkmcnt(" #n ")" ::: "memory")
#define PG8_BAR __builtin_amdgcn_s_barrier()
#define PG8_SCHED __builtin_amdgcn_sched_barrier(0)
    Unit cur, nxt; int ui = 0;
    if (!S.next(0, cur)) return;
    f32x4 acc[2][2][4][2];
#pragma unroll
    for (int a = 0; a < 2; ++a)
#pragma unroll
        for (int b = 0; b < 2; ++b)
#pragma unroll
            for (int m = 0; m < 4; ++m)
#pragma unroll
                for (int n = 0; n < 2; ++n) acc[a][b][m][n] = (f32x4){0.f, 0.f, 0.f, 0.f};
    bf16x8 At[4][2], B0[2][2], B1[2][2];
    const char* cA = (const char*)g.A + (size_t)cur.pm * tstepA; const char* cB = (const char*)g.Bt + (size_t)cur.pn * tstep;
    S.a_ready(cur);
    if constexpr (SP2) {
        PG8_STAGE(PG8_SB(0, 0), cB, voffB); PG8_STAGE(PG8_SB(0, 1), cB + hstep, voffB); PG8_STAGE(PG8_SA(0, 0), cA, voffA); PG8_STAGE(PG8_SA(0, 1), cA + hstepA, voffA);
        if (wr == 1) PG8_BAR;
        PG8_WAIT_V(2); PG8_BAR;
        PG8_STAGE(PG8_SB(1, 0), cB + kstep, voffB); PG8_STAGE(PG8_SA(1, 0), cA + kstep, voffA); PG8_STAGE(PG8_SB(1, 1), cB + hstep + kstep, voffB);
        PG8_WAIT_V(6); PG8_BAR;
    } else {
        PG8_STAGE(PG8_SB(0, 0), cB, voffB); PG8_STAGE(PG8_SA(0, 0), cA, voffA); PG8_STAGE(PG8_SB(0, 1), cB + hstep, voffB); PG8_STAGE(PG8_SA(0, 1), cA + hstepA, voffA);
        if (wr == 1) PG8_BAR;
        PG8_WAIT_V(4); PG8_BAR;
        PG8_STAGE(PG8_SB(1, 0), cB + kstep, voffB); PG8_STAGE(PG8_SA(1, 0), cA + kstep, voffA); PG8_STAGE(PG8_SB(1, 1), cB + hstep + kstep, voffB);
        PG8_WAIT_V(6); PG8_BAR;
    }
    for (;;) {
        const bool has_next = S.next(ui + 1, nxt);
        const char* nA = has_next ? (const char*)g.A + (size_t)nxt.pm * tstepA : cA; const char* nB = has_next ? (const char*)g.Bt + (size_t)nxt.pn * tstep : cB;
        for (int t = 0; t < nt; t += 2) {
            const bool last = (t == nt - 2);
            const char* a1 = cA + (size_t)(t + 1) * kstep;
            const char* a2 = last ? nA : cA + (size_t)(t + 2) * kstep; const char* b2 = last ? nB : cB + (size_t)(t + 2) * kstep;
            const char* a3 = a2 + kstep; const char* b3 = b2 + kstep;
            if (last && has_next) S.a_ready(nxt);
            if constexpr (SP2) {
            PG8_LDB(B0, 0, 0); PG8_LDB(B1, 0, 1); PG8_SCHED; PG8_LDA(At, 0, 0); PG8_STAGE(PG8_SA(1, 1), a1 + hstepA, voffA);
            PG8_WAIT_V(8); PG8_WAIT_L(0); PG8_BAR; PG8_MMA(0, 0, At, B0); PG8_MMA(0, 1, At, B1); PG8_BAR; PG8_SCHED;
            PG8_LDA(At, 0, 1); PG8_STAGE(PG8_SB(0, 0), b2, voffB); PG8_STAGE(PG8_SB(0, 1), b2 + hstep, voffB); PG8_STAGE(PG8_SA(0, 0), a2, voffA);
            PG8_WAIT_V(8); PG8_WAIT_L(0); PG8_BAR; PG8_MMA(1, 0, At, B0); PG8_MMA(1, 1, At, B1); PG8_BAR; PG8_SCHED;
            PG8_LDB(B0, 1, 0); PG8_LDB(B1, 1, 1); PG8_SCHED; PG8_LDA(At, 1, 0); PG8_STAGE(PG8_SA(0, 1), a2 + hstepA, voffA);
            PG8_WAIT_V(8); PG8_WAIT_L(0); PG8_BAR; PG8_MMA(0, 0, At, B0); PG8_MMA(0, 1, At, B1); PG8_BAR; PG8_SCHED;
            PG8_LDA(At, 1, 1); PG8_STAGE(PG8_SB(1, 0), b3, voffB); PG8_STAGE(PG8_SB(1, 1), b3 + hstep, voffB); PG8_STAGE(PG8_SA(1, 0), a3, voffA);
            PG8_WAIT_V(8); PG8_WAIT_L(0); PG8_BAR; PG8_MMA(1, 0, At, B0); PG8_MMA(1, 1, At, B1); PG8_BAR; PG8_SCHED;
            } else {
            PG8_LDB(B0, 0, 0); PG8_SCHED; PG8_LDA(At, 0, 0); PG8_STAGE(PG8_SA(1, 1), a1 + hstepA, voffA);
            PG8_WAIT_L(8); PG8_BAR; PG8_WAIT_L(0); PG8_MMA(0, 0, At, B0); PG8_BAR; PG8_SCHED;
            PG8_LDB(B1, 0, 1); PG8_STAGE(PG8_SB(0, 0), b2, voffB);
            PG8_BAR; PG8_WAIT_L(0); PG8_MMA(0, 1, At, B1); PG8_BAR;
            PG8_LDA(At, 0, 1); PG8_STAGE(PG8_SA(0, 0), a2, voffA);
            PG8_BAR; PG8_WAIT_L(0); PG8_MMA(1, 0, At, B0); PG8_BAR; PG8_SCHED;
            PG8_STAGE(PG8_SB(0, 1), b2 + hstep, voffB);
            PG8_WAIT_V(6); PG8_BAR; PG8_MMA(1, 1, At, B1); PG8_BAR;
            PG8_LDB(B0, 1, 0); PG8_SCHED; PG8_LDA(At, 1, 0); PG8_STAGE(PG8_SA(0, 1), a2 + hstepA, voffA);
            PG8_WAIT_L(8); PG8_BAR; PG8_WAIT_L(0); PG8_MMA(0, 0, At, B0); PG8_BAR; PG8_SCHED;
            PG8_LDB(B1, 1, 1); PG8_STAGE(PG8_SB(1, 0), b3, voffB);
            PG8_BAR; PG8_WAIT_L(0); PG8_MMA(0, 1, At, B1); PG8_BAR;
            PG8_LDA(At, 1, 1); PG8_STAGE(PG8_SA(1, 0), a3, voffA);
            PG8_BAR; PG8_WAIT_L(0); PG8_MMA(1, 0, At, B0); PG8_BAR; PG8_SCHED;
            PG8_STAGE(PG8_SB(1, 1), b3 + hstep, voffB);
            PG8_WAIT_V(6); PG8_BAR; PG8_MMA(1, 1, At, B1); PG8_BAR;
            }
        }
        if constexpr (ALIGN_EPI) { if (wr == 0) PG8_BAR; }
        if constexpr (!Epi::AFTER_DRAIN) { E(acc, cur, wr, wc, fr, fq); S.done(cur); }
        if (!has_next) break;
#pragma unroll
        for (int a = 0; a < 2; ++a)
#pragma unroll
            for (int b = 0; b < 2; ++b)
#pragma unroll
                for (int m = 0; m < 4; ++m)
#pragma unroll
                    for (int n = 0; n < 2; ++n) acc[a][b][m][n] = (f32x4){0.f, 0.f, 0.f, 0.f};
        cur = nxt; cA = nA; cB = nB; ++ui;
        if constexpr (ALIGN_EPI) { if (wr == 1) PG8_BAR; }
    }
    PG8_WAIT_V(0);
    if constexpr (!ALIGN_EPI) { if (wr == 0) PG8_BAR; }
    PG8_BAR;
    if constexpr (Epi::AFTER_DRAIN) { E.fused(acc, cur, wr, wc, fr, fq, lds, wid, lane); S.done(cur); }
#undef PG8_SA
#undef PG8_SB
#undef PG8_STAGE
#undef PG8_LDA
#undef PG8_LDB
#undef PG8_MMA
#undef PG8_WAIT_V
#undef PG8_WAIT_L
#undef PG8_BAR
#undef PG8_SCHED
}
}

__device__ __forceinline__ void tr_item(const float* W, int Nsrc, int K, bf16* WT, int drow0, int scol0, int nvalid, const float* kscale, LAS float* scr, int kb, int lane) {
    const int k0 = 64 * kb;
#pragma unroll 8
    for (int i = 0; i < 32; ++i) { const int kk = 2 * i + (lane >> 5), c = lane & 31; float v = 0.f;
        if (c < nvalid) v = W[(size_t)(k0 + kk) * Nsrc + scol0 + c];
        if (kscale) v *= kscale[k0 + kk];
        scr[kk * 33 + c] = v; }
    LDS_WAIT(); asm volatile("" ::: "memory");
    const int c8 = lane & 7;
#pragma unroll
    for (int j = 0; j < 4; ++j) { const int n = (lane >> 3) + 8 * j; const LAS float* s = scr + (8 * c8) * 33 + n;
        u32x4 o; o.x = pk2(s[0 * 33], s[1 * 33]); o.y = pk2(s[2 * 33], s[3 * 33]); o.z = pk2(s[4 * 33], s[5 * 33]); o.w = pk2(s[6 * 33], s[7 * 33]);
        *(u32x4*)(WT + (size_t)(drow0 + n) * K + k0 + 8 * c8) = o; }
    LDS_WAIT(); asm volatile("" ::: "memory");
}
__device__ __forceinline__ const float* x_row_ptr(int m, const float* xp, const float* meta, const float* xs) {
    if (m >= MP) return xs + (size_t)(m - MP) * D;
    const int b = m / LP, tp = m - b * LP;
    if (tp >= 64) return xp + ((size_t)b * SEQ + (tp - 64)) * D;
    if (tp >= PADR) return meta + (size_t)(tp - PADR) * D;
    return nullptr;
}
__device__ __forceinline__ void p0_prologue(const KArgs& a, LAS unsigned char* lds, int gw, int NGW, int wave, int lane, int gtid, int NT) {
    unsigned char* ws = a.ws;
    LAS float* scr = (LAS float*)(lds + wave * 16384);
    constexpr int I0 = 16 * 136, I1 = I0 + 6 * 24, I2 = I1 + 4 * 32, I3 = I2 + 8 * 32, I4 = I3 + 8 * 32, I5 = I4 + 16 * 32, I6 = I5 + 16 * 176, I7 = I6 + 44 * 32;
    for (int it = gw; it < I7; it += NGW) {
        if (it < I0) { const int kb = it / 136, g = it % 136, n0 = 32 * g; int sc, nv = 32;
            if (n0 < 1536) sc = n0;
            else if (n0 < 2304) { const int j = n0 - 1536; if (j < 384) sc = OFF_CQ + j; else if (j == 384) sc = OFF_KR; else if (j == 416) { sc = OFF_FF; nv = 8; } else if (j < 512) { sc = 0; nv = 0; } else sc = OFF_CKV + (j - 512); }
            else sc = OFF_GATE + (n0 - 2304);
            tr_item(a.in[10], INW, D, (bf16*)(ws + W_WIN), n0, sc, nv, nullptr, scr, kb, lane); }
        else if (it < I1) { const int r = it - I0, kb = r / 24, g = r % 24; tr_item(a.in[13], 768, 384, (bf16*)(ws + W_WUQ), 32 * g, 32 * g, 32, nullptr, scr, kb, lane); }
        else if (it < I2) { const int r = it - I1, kb = r / 32, g = r % 32; tr_item(a.in[15], 1024, 256, (bf16*)(ws + W_WUKV), 32 * g, 32 * g, 32, nullptr, scr, kb, lane); }
        else if (it < I3) { const int r = it - I2, kb = r / 32, g = r % 32; tr_item(a.in[16], 1024, 512, (bf16*)(ws + W_WOF), 32 * g, 32 * g, 32, nullptr, scr, kb, lane); }
        else if (it < I4) { const int r = it - I3, kb = r / 32, g = r % 32; tr_item(a.in[17], 1024, 512, (bf16*)(ws + W_WOM), 32 * g, 32 * g, 32, nullptr, scr, kb, lane); }
        else if (it < I5) { const int r = it - I4, kb = r / 32, g = r % 32; tr_item(a.in[18], 1024, 1024, (bf16*)(ws + W_WOUT), 32 * g, 32 * g, 32, nullptr, scr, kb, lane); }
        else if (it < I6) { const int r = it - I5, kb = r / 176, g = r % 176, n0 = 32 * g, pn = n0 >> 8, jj = n0 & 255, bj = jj >> 7, ch = 128 * pn + (jj & 127);
            tr_item(a.in[20], UPW, D, (bf16*)(ws + W_WUP), n0, bj * DFF + ch, 32, a.in[19], scr, kb, lane); }
        else { const int r = it - I6, kb = r / 32, g = r % 32; tr_item(a.in[23], 1024, DFF, (bf16*)(ws + W_WDN), 32 * g, 32 * g, 32, nullptr, scr, kb, lane); }
    }
    { const float* gm = a.in[9]; f32x4 gv[4];
#pragma unroll
        for (int j = 0; j < 4; ++j) gv[j] = *(const f32x4*)(gm + 4 * lane + 256 * j);
        bf16* XN = (bf16*)(ws + W_XN);
        for (int m = gw; m < MT; m += NGW) { const float* xr = x_row_ptr(m, a.in[0], a.in[8], a.in[1]);
            f32x4 v[4]; float s = 0.f;
#pragma unroll
            for (int j = 0; j < 4; ++j) { v[j] = xr ? *(const f32x4*)(xr + 4 * lane + 256 * j) : (f32x4){0.f, 0.f, 0.f, 0.f}; s += (v[j][0] * v[j][0] + v[j][1] * v[j][1]) + (v[j][2] * v[j][2] + v[j][3] * v[j][3]); }
            const float rstd = __builtin_amdgcn_rsqf(wave_sum(s) * (1.f / D) + EPS);
#pragma unroll
            for (int j = 0; j < 4; ++j) { const f32x4 o = v[j] * rstd * gv[j]; *(u32x2*)(XN + (size_t)m * D + 4 * lane + 256 * j) = (u32x2){pk2(o[0], o[1]), pk2(o[2], o[3])}; } } }
    { bf16* FK = (bf16*)(ws + W_FK); bf16* FV = (bf16*)(ws + W_FV);
        for (int t = gw; t < SB * SXR; t += NGW) { const int sb = t / SXR, j = t - sb * SXR; if (j >= PAST && j < PAST + SN) continue;
            const size_t er = (size_t)(MP + t) * 512 + 8 * lane; u32x4 k = {0u, 0u, 0u, 0u}, v = {0u, 0u, 0u, 0u};
            if (j < PAST) { const size_t src = ((size_t)sb * PAST + j) * 512 + 8 * lane; k = pk8(*(const f32x4*)(a.in[2] + src), *(const f32x4*)(a.in[2] + src + 4)); v = pk8(*(const f32x4*)(a.in[3] + src), *(const f32x4*)(a.in[3] + src + 4)); }
            *(u32x4*)(FK + er) = k; *(u32x4*)(FV + er) = v; } }
    { float* s2 = (float*)(ws + W_SS2); float* s3 = (float*)(ws + W_SS3); for (int i = gtid; i < MT; i += NT) { s2[i] = 0.f; s3[i] = 0.f; }
        float* rp = (float*)(ws + W_ROPE);
        for (int i = gtid; i < LSEQ * 16; i += NT) { const int pos = i >> 4, k = i & 15; const float inv = exp2f(-(float)k * (13.287712379549449f / 16.f)); const float ang = (float)pos * inv;
            const double rev = (double)ang * 0.15915494309189535; const double fr = rev - __builtin_rint(rev); const float f = (float)fr;
            rp[2 * i] = __builtin_amdgcn_cosf(f); rp[2 * i + 1] = __builtin_amdgcn_sinf(f); } }
}
__device__ __forceinline__ void p2_fixup(const KArgs& a, int gw, int NGW, int lane) {
    unsigned char* ws = a.ws; const float* MISC = (const float*)(ws + W_MISC); bf16* CQ = (bf16*)(ws + W_CQ); bf16* CKVN = (bf16*)(ws + W_CKVN); bf16* KR = (bf16*)(ws + W_KR);
    float* LOGF = (float*)(ws + W_LOGF); const float* rope = (const float*)(ws + W_ROPE); float* out = a.out;
    const f32x4 gq0 = *(const f32x4*)(a.in[12] + 4 * lane), gq1 = lane < 32 ? *(const f32x4*)(a.in[12] + 256 + 4 * lane) : (f32x4){0.f, 0.f, 0.f, 0.f}, gk = *(const f32x4*)(a.in[14] + 4 * lane);
    f32x4 bfv = {0.f, 0.f, 0.f, 0.f}; if (lane == 40 || lane == 41) bfv = *(const f32x4*)(a.in[11] + 4 * (lane - 40));
    for (int m = gw; m < MT; m += NGW) { const float* mr = MISC + (size_t)m * 768;
        const f32x4 v0 = *(const f32x4*)(mr + 4 * lane), v1 = *(const f32x4*)(mr + 256 + 4 * lane), v2 = *(const f32x4*)(mr + 512 + 4 * lane);
        float sq = (v0[0] * v0[0] + v0[1] * v0[1]) + (v0[2] * v0[2] + v0[3] * v0[3]); if (lane < 32) sq += (v1[0] * v1[0] + v1[1] * v1[1]) + (v1[2] * v1[2] + v1[3] * v1[3]);
        float sk = (v2[0] * v2[0] + v2[1] * v2[1]) + (v2[2] * v2[2] + v2[3] * v2[3]);
        const float rq = __builtin_amdgcn_rsqf(wave_sum(sq) * (1.f / 384.f) + EPS), rk = __builtin_amdgcn_rsqf(wave_sum(sk) * (1.f / 256.f) + EPS);
        const int er = ext_row(m), orow = out_row(m), pos = pos_of(m);
        { const f32x4 c = v0 * rq * gq0; *(u32x2*)(CQ + (size_t)m * 384 + 4 * lane) = (u32x2){pk2(c[0], c[1]), pk2(c[2], c[3])}; }
        if (lane < 32) { const f32x4 c = v1 * rq * gq1; *(u32x2*)(CQ + (size_t)m * 384 + 256 + 4 * lane) = (u32x2){pk2(c[0], c[1]), pk2(c[2], c[3])}; }
        { const f32x4 c = v2 * rk * gk; *(u32x2*)(CKVN + (size_t)er * 256 + 4 * lane) = (u32x2){pk2(c[0], c[1]), pk2(c[2], c[3])};
            if (orow >= 0) *(f32x4*)(out + O_CKVP + (size_t)orow * 256 + 4 * lane) = c; else if (orow != (int)0x80000000) *(f32x4*)(out + O_CKVS + (size_t)(-1 - orow) * 256 + 4 * lane) = c; }
        f32x4 pt;
#pragma unroll
        for (int e = 0; e < 4; ++e) pt[e] = __shfl_xor(v1[e], 4);
        if (lane >= 32 && lane < 40) { const int i = lane - 32; const bool first = i < 4; const float* t = rope + ((size_t)pos * 16 + 4 * (i & 3)) * 2;
            const f32x4 t0 = *(const f32x4*)t, t1 = *(const f32x4*)(t + 4); const float sg = first ? -1.f : 1.f; f32x4 c;
            c[0] = v1[0] * t0[0] + sg * pt[0] * t0[1]; c[1] = v1[1] * t0[2] + sg * pt[1] * t0[3]; c[2] = v1[2] * t1[0] + sg * pt[2] * t1[1]; c[3] = v1[3] * t1[2] + sg * pt[3] * t1[3];
            *(u32x2*)(KR + (size_t)er * 32 + 4 * i) = (u32x2){pk2(c[0], c[1]), pk2(c[2], c[3])};
            if (orow >= 0) *(f32x4*)(out + O_KRP + (size_t)orow * 32 + 4 * i) = c; else if (orow != (int)0x80000000) *(f32x4*)(out + O_KRS + (size_t)(-1 - orow) * 32 + 4 * i) = c; }
        if (lane == 40 || lane == 41) { const int i = lane - 40; f32x4 c;
#pragma unroll
            for (int e = 0; e < 4; ++e) { const float z = v1[e] + bfv[e]; c[e] = fminf(z, 0.f) - log1pf(__expf(-fabsf(z))); }
            *(f32x4*)(LOGF + (size_t)er * 8 + 4 * i) = c;
            if (orow >= 0) *(f32x4*)(out + O_LFP + (size_t)orow * 8 + 4 * i) = c; else if (orow != (int)0x80000000) *(f32x4*)(out + O_LFS + (size_t)(-1 - orow) * 8 + 4 * i) = c; }
    }
    for (int t = gw; t < SB * SXR; t += NGW) { const int sb = t / SXR, j = t - sb * SXR; if (j >= PAST && j < PAST + SN) continue;
        const size_t er = (size_t)(MP + t); const bool c = j < PAST; const size_t sr = (size_t)sb * PAST + j;
        { f32x4 v = {0.f, 0.f, 0.f, 0.f}; if (c) v = *(const f32x4*)(a.in[5] + sr * 256 + 4 * lane); *(u32x2*)(CKVN + er * 256 + 4 * lane) = (u32x2){pk2(v[0], v[1]), pk2(v[2], v[3])}; }
        if (lane < 8) { f32x4 v = {0.f, 0.f, 0.f, 0.f}; if (c) v = *(const f32x4*)(a.in[6] + sr * 32 + 4 * lane); *(u32x2*)(KR + er * 32 + 4 * lane) = (u32x2){pk2(v[0], v[1]), pk2(v[2], v[3])}; }
        if (lane < 2) { f32x4 v = {0.f, 0.f, 0.f, 0.f}; if (c) v = *(const f32x4*)(a.in[4] + sr * 8 + 4 * lane); *(f32x4*)(LOGF + er * 8 + 4 * lane) = v; } }
}
__device__ __forceinline__ void p3_scan(const KArgs& a, int gw, int NGW, int lane) {
    const float* LOGF = (const float*)(a.ws + W_LOGF); float* FB = (float*)(a.ws + W_FB);
    for (int s = gw; s < NB * NH + SB * NH; s += NGW) { int base, nch, h;
        if (s < NB * NH) { base = (s >> 3) * LP; nch = LP / 64; h = s & 7; } else { const int t = s - NB * NH; base = MP + (t >> 3) * SXR; nch = SXR / 64; h = t & 7; }
        float carry = 0.f;
        for (int c = 0; c < nch; ++c) { float v = LOGF[(size_t)(base + 64 * c + lane) * 8 + h];
#pragma unroll
            for (int o = 1; o < 64; o <<= 1) { const float t = __shfl_up(v, o); if (lane >= o) v += t; }
            v += carry; FB[(size_t)h * ER + base + 64 * c + lane] = -v * LOG2E; carry = __shfl(v, 63); } }
}
__device__ __forceinline__ void p9_final(const KArgs& a, int gw, int NGW, int lane) {
    const float* H = (const float*)(a.ws + W_H1); const float* SS = (const float*)(a.ws + W_SS3); const float* g = a.in[24]; f32x4 gv[4];
#pragma unroll
    for (int j = 0; j < 4; ++j) gv[j] = *(const f32x4*)(g + 4 * lane + 256 * j);
    for (int m = gw; m < MT; m += NGW) { float* o;
        if (m >= MP) o = a.out + O_YS + (size_t)(m - MP) * D; else { const int b = m / LP, tp = m - b * LP; if (tp < 64) continue; o = a.out + O_YP + ((size_t)b * SEQ + (tp - 64)) * D; }
        const float rstd = __builtin_amdgcn_rsqf(SS[m] * (1.f / D) + EPS);
#pragma unroll
        for (int j = 0; j < 4; ++j) *(f32x4*)(o + 4 * lane + 256 * j) = *(const f32x4*)(H + (size_t)m * D + 4 * lane + 256 * j) * rstd * gv[j]; }
}

struct AttnP { const bf16* Q; const bf16* K1; const bf16* K2; const bf16* V; const float* FB; bf16* O; int qpitch, k1pitch, vpitch, opitch, ntiles, q0, nq, cmode, kvlo, qlo, kvhi; float sl2; };
typedef short v4i16_t __attribute__((ext_vector_type(4)));
#define MFMA32(a, b, c) __builtin_amdgcn_mfma_f32_32x32x16_bf16((a), (b), (c), 0, 0, 0)
template <int DK> __device__ __forceinline__ void attn_tile(LAS unsigned char* kb, const bf16x8 (&qf)[DK / 16], f32x16& o0, f32x16& o1, float& m_run, float& l_run,
                                                            bool hasfb, float sl2, int kvbase, bool needmask, int lo_l, int hi_l, int lane) {
    constexpr int KP = DK == 64 ? 144 : 208, VP = 144, KBYTES = 64 * KP, VBYTES = 64 * VP;
    const int r = lane & 31, h = lane >> 5;
    f32x16 p0, p1;
#pragma unroll
    for (int i = 0; i < 16; ++i) { p0[i] = 0.f; p1[i] = 0.f; }
#pragma unroll
    for (int d0 = 0; d0 < DK / 16; ++d0) { const bf16x8 ka = *(const LAS bf16x8*)(kb + r * KP + (16 * d0 + 8 * h) * 2), kc = *(const LAS bf16x8*)(kb + (32 + r) * KP + (16 * d0 + 8 * h) * 2);
        p0 = MFMA32(ka, qf[d0], p0); p1 = MFMA32(kc, qf[d0], p1); }
    if (hasfb) { const LAS float* fb = (const LAS float*)(kb + KBYTES + VBYTES);
#pragma unroll
        for (int g = 0; g < 4; ++g) { const f32x4 f0 = *(const LAS f32x4*)(fb + 8 * g + 4 * h), f1 = *(const LAS f32x4*)(fb + 32 + 8 * g + 4 * h);
#pragma unroll
            for (int e = 0; e < 4; ++e) { p0[4 * g + e] = p0[4 * g + e] * sl2 + f0[e]; p1[4 * g + e] = p1[4 * g + e] * sl2 + f1[e]; } } }
    else {
#pragma unroll
        for (int i = 0; i < 16; ++i) { p0[i] *= sl2; p1[i] *= sl2; } }
    if (needmask) {
#pragma unroll
        for (int i = 0; i < 16; ++i) { const int kv = kvbase + (i & 3) + 8 * (i >> 2) + 4 * h;
            if (kv < lo_l || kv > hi_l) p0[i] = -INFINITY;
            if (kv + 32 < lo_l || kv + 32 > hi_l) p1[i] = -INFINITY; } }
    float mx = fmaxf(p0[0], p1[0]);
#pragma unroll
    for (int i = 1; i < 16; ++i) mx = fmaxf(mx, fmaxf(p0[i], p1[i]));
    mx = fmaxf(mx, __shfl_xor(mx, 32));
    const float mnew = fmaxf(m_run, mx), muse = (mnew == -INFINITY) ? 0.f : mnew;
    const float alpha = __builtin_amdgcn_exp2f(m_run - muse);
    m_run = mnew;
    float ps = 0.f;
#pragma unroll
    for (int i = 0; i < 16; ++i) { p0[i] = __builtin_amdgcn_exp2f(p0[i] - muse); p1[i] = __builtin_amdgcn_exp2f(p1[i] - muse); ps += p0[i] + p1[i]; }
    l_run = l_run * alpha + ps;
#pragma unroll
    for (int i = 0; i < 16; ++i) { o0[i] *= alpha; o1[i] *= alpha; }
    bf16x8 pf[4];
#pragma unroll
    for (int s2 = 0; s2 < 2; ++s2) {
        u32x4 w0 = {pk2(p0[8 * s2], p0[8 * s2 + 1]), pk2(p0[8 * s2 + 2], p0[8 * s2 + 3]), pk2(p0[8 * s2 + 4], p0[8 * s2 + 5]), pk2(p0[8 * s2 + 6], p0[8 * s2 + 7])};
        u32x4 w1 = {pk2(p1[8 * s2], p1[8 * s2 + 1]), pk2(p1[8 * s2 + 2], p1[8 * s2 + 3]), pk2(p1[8 * s2 + 4], p1[8 * s2 + 5]), pk2(p1[8 * s2 + 6], p1[8 * s2 + 7])};
        pf[s2] = __builtin_bit_cast(bf16x8, w0); pf[2 + s2] = __builtin_bit_cast(bf16x8, w1); }
    const int i16 = lane & 15, q4 = i16 >> 2, p4 = i16 & 3, blk = (lane >> 4) & 1;
    LAS unsigned char* vl = kb + KBYTES + (4 * h + q4) * VP + 32 * blk + 8 * p4;
#pragma unroll
    for (int k = 0; k < 4; ++k) {
#pragma unroll
        for (int db = 0; db < 2; ++db) {
            const s16x4 lo = __builtin_bit_cast(s16x4, __builtin_amdgcn_ds_read_tr16_b64_v4i16((LAS v4i16_t*)(vl + (16 * k) * VP + 64 * db)));
            const s16x4 hi = __builtin_bit_cast(s16x4, __builtin_amdgcn_ds_read_tr16_b64_v4i16((LAS v4i16_t*)(vl + (16 * k + 8) * VP + 64 * db)));
            const bf16x8 vf = __builtin_shufflevector(lo, hi, 0, 1, 2, 3, 4, 5, 6, 7);
            if (db == 0) o0 = MFMA32(vf, pf[k], o0); else o1 = MFMA32(vf, pf[k], o1); } }
}
template <int DK> __device__ __forceinline__ void attn_unit(LAS unsigned char* lds, const AttnP& P) {
    constexpr int KP = DK == 64 ? 144 : 208, VP = 144, KBYTES = 64 * KP, VBYTES = 64 * VP, BUF = KBYTES + VBYTES + 256, ND = DK / 16;
    int tid_ = threadIdx.x; asm volatile("" : "+v"(tid_));
    const int tid = tid_, lane = tid & 63, wid = __builtin_amdgcn_readfirstlane(tid >> 6), r = lane & 31, h = lane >> 5;
    const int lrow = tid >> 3, lch = tid & 7;
    const int q_abs = P.q0 + 32 * wid + r;
    const int qlim = P.cmode == 1 ? q_abs : (P.cmode == 2 ? (q_abs | 63) : 0x7fffffff);
    const int hi_l = qlim < P.kvhi - 1 ? qlim : P.kvhi - 1, lo_l = q_abs >= P.qlo ? P.kvlo : 0;
    int mxh = hi_l, mnh = hi_l, mxl = lo_l;
#pragma unroll
    for (int o = 1; o < 64; o <<= 1) { const int a1 = __shfl_xor(mxh, o), a2 = __shfl_xor(mnh, o), a3 = __shfl_xor(mxl, o); mxh = a1 > mxh ? a1 : mxh; mnh = a2 < mnh ? a2 : mnh; mxl = a3 > mxl ? a3 : mxl; }
    mxh = __builtin_amdgcn_readfirstlane(mxh); mnh = __builtin_amdgcn_readfirstlane(mnh); mxl = __builtin_amdgcn_readfirstlane(mxl);
    const bool active = 32 * wid < P.nq;
    const int last_tile = (mxh >> 6) < P.ntiles - 1 ? (mxh >> 6) : P.ntiles - 1;
    bf16x8 qf[ND];
#pragma unroll
    for (int d0 = 0; d0 < ND; ++d0) { if (active) qf[d0] = *(const bf16x8*)(P.Q + (size_t)(32 * wid + r) * P.qpitch + 16 * d0 + 8 * h); else qf[d0] = (bf16x8){0, 0, 0, 0, 0, 0, 0, 0}; }
    float m_run = -INFINITY, l_run = 0.f; f32x16 o0, o1;
#pragma unroll
    for (int i = 0; i < 16; ++i) { o0[i] = 0.f; o1[i] = 0.f; }
    u32x4 rk1 = {0u, 0u, 0u, 0u}, rk2 = {0u, 0u, 0u, 0u}, rv = {0u, 0u, 0u, 0u}; f32x4 rfb = {0.f, 0.f, 0.f, 0.f};
    const bool hasfb = P.FB != nullptr;
#define A_LOAD(jt) do { const size_t kr_ = (size_t)((jt) * 64 + lrow); rk1 = *(const u32x4*)(P.K1 + kr_ * P.k1pitch + lch * 8); rv = *(const u32x4*)(P.V + kr_ * P.vpitch + lch * 8); \
        if (DK == 96 && tid < 256) rk2 = *(const u32x4*)(P.K2 + (size_t)((jt) * 64 + (tid >> 2)) * 32 + (tid & 3) * 8); \
        if (hasfb && tid < 16) rfb = *(const f32x4*)(P.FB + (jt) * 64 + tid * 4); } while (0)
#define A_STORE(b) do { LAS unsigned char* kb_ = lds + (b) * BUF; *(LAS u32x4*)(kb_ + lrow * KP + lch * 16) = rk1; *(LAS u32x4*)(kb_ + KBYTES + lrow * VP + lch * 16) = rv; \
        if (DK == 96 && tid < 256) *(LAS u32x4*)(kb_ + (tid >> 2) * KP + 128 + (tid & 3) * 16) = rk2; \
        if (hasfb && tid < 16) *(LAS f32x4*)(kb_ + KBYTES + VBYTES + tid * 16) = rfb; } while (0)
    A_LOAD(0); A_STORE(0); __syncthreads();
    for (int jt = 0; jt < P.ntiles; ++jt) {
        const bool more = jt + 1 < P.ntiles;
        if (more) A_LOAD(jt + 1);
        if (active && jt <= last_tile) { const int kvbase = jt * 64; const bool needmask = (kvbase < mxl) || (kvbase + 63 > mnh);
            attn_tile<DK>(lds + (jt & 1) * BUF, qf, o0, o1, m_run, l_run, hasfb, P.sl2, kvbase, needmask, lo_l, hi_l, lane); }
        if (more) A_STORE((jt + 1) & 1);
        __syncthreads();
    }
#undef A_LOAD
#undef A_STORE
    const float l = l_run + __shfl_xor(l_run, 32), rl = 1.f / l;
    if (active && 32 * wid + r < P.nq) { bf16* op = P.O + (size_t)(32 * wid + r) * P.opitch + 4 * h;
#pragma unroll
        for (int g = 0; g < 4; ++g) {
            *(u32x2*)(op + 8 * g) = (u32x2){pk2(o0[4 * g] * rl, o0[4 * g + 1] * rl), pk2(o0[4 * g + 2] * rl, o0[4 * g + 3] * rl)};
            *(u32x2*)(op + 32 + 8 * g) = (u32x2){pk2(o1[4 * g] * rl, o1[4 * g + 1] * rl), pk2(o1[4 * g + 2] * rl, o1[4 * g + 3] * rl)}; } }
}
__device__ __forceinline__ void p4_attention(const KArgs& a, LAS unsigned char* lds, int vcu, int G) {
    unsigned char* ws = a.ws; bf16* FQ = (bf16*)(ws + W_FQ); const bf16* FK = (const bf16*)(ws + W_FK); const bf16* FV = (const bf16*)(ws + W_FV); const float* FB = (const float*)(ws + W_FB);
    const bf16* QM = (const bf16*)(ws + W_QMLA); const bf16* KV = (const bf16*)a.out; const bf16* KR = (const bf16*)(ws + W_KR); bf16* OM = (bf16*)(ws + W_OM);
    const float slf = 0.125f * LOG2E, slm = 0.10206207261596575f * LOG2E;
    for (int c = vcu; c < 256; c += G) { const int b = c >> 3, h = c & 7; const size_t r0 = (size_t)b * LP;
        for (int blk = 8; blk >= 0; --blk) { const int q0 = blk == 0 ? 0 : 64 + 256 * (blk - 1), nq = blk == 0 ? 64 : 256, nt = 4 * blk + 1;
            { AttnP P; P.Q = FQ + (r0 + q0) * 512 + h * 64; P.K1 = FK + r0 * 512 + h * 64; P.K2 = nullptr; P.V = FV + r0 * 512 + h * 64; P.FB = FB + (size_t)h * ER + r0; P.O = FQ + (r0 + q0) * 512 + h * 64;
                P.qpitch = 512; P.k1pitch = 512; P.vpitch = 512; P.opitch = 512; P.ntiles = nt; P.q0 = q0; P.nq = nq; P.cmode = 1; P.kvlo = PADR; P.qlo = PADR; P.kvhi = LP; P.sl2 = slf;
                attn_unit<64>(lds, P); }
            { AttnP P; P.Q = QM + (r0 + q0) * 768 + h * 96; P.K1 = KV + r0 * 1024 + h * 128; P.K2 = KR + r0 * 32; P.V = KV + r0 * 1024 + h * 128 + 64; P.FB = nullptr; P.O = OM + (r0 + q0) * 512 + h * 64;
                P.qpitch = 768; P.k1pitch = 1024; P.vpitch = 1024; P.opitch = 512; P.ntiles = nt; P.q0 = q0; P.nq = nq; P.cmode = 2; P.kvlo = PADR; P.qlo = PADR; P.kvhi = LP; P.sl2 = slm;
                attn_unit<96>(lds, P); } }
        { const int typ = c >> 7, sb = (c & 127) >> 3; const size_t e0 = (size_t)MP + (size_t)sb * SXR, t0 = (size_t)MP + (size_t)sb * SN;
            if (typ == 0) { AttnP P; P.Q = FQ + t0 * 512 + h * 64; P.K1 = FK + e0 * 512 + h * 64; P.K2 = nullptr; P.V = FV + e0 * 512 + h * 64; P.FB = FB + (size_t)h * ER + e0; P.O = FQ + t0 * 512 + h * 64;
                P.qpitch = 512; P.k1pitch = 512; P.vpitch = 512; P.opitch = 512; P.ntiles = 17; P.q0 = PAST; P.nq = SN; P.cmode = 1; P.kvlo = 0; P.qlo = 0; P.kvhi = PAST + SN; P.sl2 = slf;
                attn_unit<64>(lds, P); }
            else { AttnP P; P.Q = QM + t0 * 768 + h * 96; P.K1 = KV + e0 * 1024 + h * 128; P.K2 = KR + e0 * 32; P.V = KV + e0 * 1024 + h * 128 + 64; P.FB = nullptr; P.O = OM + t0 * 512 + h * 64;
                P.qpitch = 768; P.k1pitch = 1024; P.vpitch = 1024; P.opitch = 512; P.ntiles = 17; P.q0 = PAST; P.nq = SN; P.cmode = 0; P.kvlo = 0; P.qlo = 0; P.kvhi = PAST + SN; P.sl2 = slm;
                attn_unit<96>(lds, P); } }
    }
}

constexpr int LDS_BYTES = 147456;
__global__ void __launch_bounds__(512, 2) mega_fwd(KArgs a) {
    extern __shared__ __attribute__((aligned(16))) unsigned char lds_raw[];
    cg::grid_group grid = cg::this_grid();
    LAS unsigned char* lds = (LAS unsigned char*)lds_raw;
    const int G = gridDim.x, bx = blockIdx.x, vcu = (G % 8 == 0) ? (bx % 8) * (G / 8) + bx / 8 : bx;
    const int NGW = G * 8, NT = G * 512;
#define LANEVARS int t_ = threadIdx.x; asm volatile("" : "+v"(t_)); const int lane = t_ & 63, wave = __builtin_amdgcn_readfirstlane(t_ >> 6), gw = vcu * 8 + wave, gtid = bx * 512 + t_; (void)gtid; (void)lane; (void)gw
    unsigned char* ws = a.ws;
    const pg8::AMap nat{0, 0, 256};
#ifndef SKIP_P0
    { LANEVARS; p0_prologue(a, lds, gw, NGW, wave, lane, gtid, NT); }
#endif
    __syncthreads(); grid.sync();
#ifndef SKIP_P1
    { pg8::Gemm g{(const bf16*)(ws + W_XN), (const bf16*)(ws + W_WIN), MT, INWP, D}; pg8::StaticOrder S; S.init(MT, INWP, G, bx);
        pg8::EpiWin E{(bf16*)(ws + W_FQ), (bf16*)(ws + W_FK), (bf16*)(ws + W_FV), (bf16*)(ws + W_GATES), (float*)(ws + W_MISC), a.out};
        pg8::gemm_phase<pg8::EpiWin, pg8::StaticOrder, true, true>(lds, g, S, E, nat); }
#endif
    __syncthreads(); grid.sync();
#ifndef SKIP_P2
    { LANEVARS; p2_fixup(a, gw, NGW, lane); }
#endif
    __syncthreads(); grid.sync();
#ifndef SKIP_P3
#ifndef SKIP_SCAN
    { LANEVARS; p3_scan(a, gw, NGW, lane); }
#endif
#ifndef SKIP_P3A
    { pg8::Gemm g{(const bf16*)(ws + W_CQ), (const bf16*)(ws + W_WUQ), MT, 768, 384}; pg8::StaticOrder S; S.init(MT, 768, G, bx);
        pg8::EpiQ E{(bf16*)(ws + W_QMLA), (const float*)(ws + W_ROPE)};
        pg8::gemm_phase<pg8::EpiQ, pg8::StaticOrder, true, true>(lds, g, S, E, nat); }
#endif
#ifndef SKIP_P3B
    { pg8::Gemm g{(const bf16*)(ws + W_CKVN), (const bf16*)(ws + W_WUKV), ER, 1024, 256}; pg8::StaticOrder S; S.init(ER, 1024, G, bx);
        pg8::EpiPlain E{(bf16*)a.out, 1024};
        pg8::gemm_phase<pg8::EpiPlain, pg8::StaticOrder, true, true>(lds, g, S, E, nat); }
#endif
#endif
    __syncthreads(); grid.sync();
#ifndef SKIP_P4
    p4_attention(a, lds, vcu, G);
#endif
    __syncthreads(); grid.sync();
#ifndef SKIP_P5
    { pg8::Gemm g{(const bf16*)(ws + W_FQ), (const bf16*)(ws + W_WOF), MT, D, 512}; pg8::StaticOrder S; S.init(MT, D, G, bx);
        pg8::EpiMix<0> E{(bf16*)(ws + W_MIX), (const bf16*)(ws + W_GATES)};
        pg8::gemm_phase<pg8::EpiMix<0>, pg8::StaticOrder, true, true>(lds, g, S, E, nat); }
    { pg8::Gemm g{(const bf16*)(ws + W_OM), (const bf16*)(ws + W_WOM), MT, D, 512}; pg8::StaticOrder S; S.init(MT, D, G, bx);
        pg8::EpiMix<1> E{(bf16*)(ws + W_MIX), (const bf16*)(ws + W_GATES)};
        pg8::gemm_phase<pg8::EpiMix<1>, pg8::StaticOrder, true, true>(lds, g, S, E, nat); }
#endif
    __syncthreads(); grid.sync();
#ifndef SKIP_P6
    { pg8::Gemm g{(const bf16*)(ws + W_MIX), (const bf16*)(ws + W_WOUT), MT, D, D}; pg8::StaticOrder S; S.init(MT, D, G, bx);
        pg8::EpiH1 E{a.in[0], a.in[8], a.in[1], (float*)(ws + W_H1), (bf16*)(ws + W_H1B), (float*)(ws + W_SS2)};
        pg8::gemm_phase<pg8::EpiH1, pg8::StaticOrder, true, true>(lds, g, S, E, nat); }
#endif
    __syncthreads(); grid.sync();
#ifndef SKIP_P7
    { pg8::Gemm g{(const bf16*)(ws + W_H1B), (const bf16*)(ws + W_WUP), 269 * 256, UPW, D}; pg8::StaticOrder S; S.init(269 * 256, UPW, G, bx);
        pg8::EpiConv<false> E{(bf16*)(ws + W_G), (const float*)(ws + W_SS2), a.in[21], a.in[22], a.in[7], a.out, 126};
        pg8::gemm_phase<pg8::EpiConv<false>, pg8::StaticOrder, true, true>(lds, g, S, E, pg8::AMap{1, 126, 252}); }
    { pg8::Gemm g{(const bf16*)(ws + W_H1B) + (size_t)MP * D, (const bf16*)(ws + W_WUP), 256, UPW, D}; pg8::StaticOrder S; S.init(256, UPW, G, G - 1 - bx);
        pg8::EpiConv<true> E{(bf16*)(ws + W_G), (const float*)(ws + W_SS2), a.in[21], a.in[22], a.in[7], a.out, 128};
        pg8::gemm_phase<pg8::EpiConv<true>, pg8::StaticOrder, true, true>(lds, g, S, E, pg8::AMap{1, 128, 256}); }
#endif
    __syncthreads(); grid.sync();
#ifndef SKIP_P8
    { pg8::Gemm g{(const bf16*)(ws + W_G), (const bf16*)(ws + W_WDN), MT, D, DFF}; pg8::StaticOrder S; S.init(MT, D, G, bx);
        pg8::EpiH2 E{(float*)(ws + W_H1), (float*)(ws + W_SS3)};
        pg8::gemm_phase<pg8::EpiH2, pg8::StaticOrder, true, true>(lds, g, S, E, nat); }
#endif
    __syncthreads(); grid.sync();
#ifndef SKIP_P9
    { LANEVARS; p9_final(a, gw, NGW, lane); }
#endif
}

extern "C" void kernel_launch(void* const* d_in, const int* in_sizes, int n_in, void* d_out, int out_size, void* d_ws, size_t ws_size, hipStream_t stream) {
    static int grid = 0;
    if (grid == 0) {
        if (n_in != 25 || (size_t)out_size != O_END || ws_size < W_END) { fprintf(stderr, "kernel_launch: unexpected sizes n_in %d out %d (want %zu) ws %zu (want %zu)\n", n_in, out_size, (size_t)O_END, ws_size, (size_t)W_END); grid = -1; return; }
        int dev = 0, cus = 0, per_cu = 0;
        hipGetDevice(&dev); hipDeviceGetAttribute(&cus, hipDeviceAttributeMultiprocessorCount, dev);
        hipFuncSetAttribute((const void*)mega_fwd, hipFuncAttributeMaxDynamicSharedMemorySize, LDS_BYTES);
        hipOccupancyMaxActiveBlocksPerMultiprocessor(&per_cu, (const void*)mega_fwd, 512, LDS_BYTES);
        (void)hipGetLastError();
        if (per_cu < 1) per_cu = 1;
        grid = cus;
        if (grid > 256) grid = 256;
    }
    if (grid < 0) return;
    KArgs a{};
    for (int i = 0; i < 25; ++i) a.in[i] = (const float*)d_in[i];
    a.out = (float*)d_out; a.ws = (unsigned char*)d_ws;
    void* args[] = {&a};
    hipError_t e = hipLaunchCooperativeKernel((const void*)mega_fwd, dim3(grid), dim3(512), args, LDS_BYTES, stream);
    if (e != hipSuccess) fprintf(stderr, "cooperative launch failed: %s (grid %d)\n", hipGetErrorString(e), grid);
}
```

```cpp
#include <hip/hip_runtime.h>
#include <hip/hip_cooperative_groups.h>
#include <cstdio>
#include <cstdint>
namespace cg = cooperative_groups;

constexpr int D = 1024, NB = 32, SEQ = 2048, NMETA = 16, LSEQ = 2064, PADR = 48, LP = 2112;
constexpr int MP = NB * LP;
constexpr int SB = 16, SN = 16, PAST = 1024, MS = SB * SN;
constexpr int MT = MP + MS;
constexpr int MTA = MT + 256;
constexpr int SXR = 1088;
constexpr int ER = MP + SB * SXR;
constexpr int NH = 8, INW = 4264, INWP = 4352, DFF = 2816, UPW = 5632;
constexpr int OFF_FF = 1536, OFF_CQ = 1544, OFF_CKV = 1928, OFF_KR = 2184, OFF_GATE = 2216;
constexpr float EPS = 1e-6f, LOG2E = 1.4426950408889634f;
constexpr size_t O_YP = 0, O_YS = O_YP + (size_t)NB * SEQ * D, O_KP = O_YS + (size_t)MS * D, O_VP = O_KP + (size_t)NB * LSEQ * 512, O_LFP = O_VP + (size_t)NB * LSEQ * 512,
                 O_CKVP = O_LFP + (size_t)NB * LSEQ * 8, O_KRP = O_CKVP + (size_t)NB * LSEQ * 256, O_CVP = O_KRP + (size_t)NB * LSEQ * 32, O_KS = O_CVP + (size_t)NB * 2 * UPW,
                 O_VS = O_KS + (size_t)MS * 512, O_LFS = O_VS + (size_t)MS * 512, O_CKVS = O_LFS + (size_t)MS * 8, O_KRS = O_CKVS + (size_t)MS * 256, O_CVS = O_KRS + (size_t)MS * 32,
                 O_END = O_CVS + (size_t)SB * 2 * UPW;
constexpr size_t AL(size_t x) { return (x + 4095) & ~(size_t)4095; }
constexpr size_t W_WIN = 0, W_WUQ = AL(W_WIN + (size_t)INWP * D * 2), W_WUKV = AL(W_WUQ + (size_t)768 * 384 * 2), W_WOC = AL(W_WUKV + (size_t)1024 * 256 * 2),
                 W_WOUT = AL(W_WOC + (size_t)1024 * 1024 * 2), W_WUP = AL(W_WOUT + (size_t)D * D * 2), W_WDN = AL(W_WUP + (size_t)UPW * D * 2), W_ROPE = AL(W_WDN + (size_t)D * DFF * 2),
                 W_SS2 = AL(W_ROPE + (size_t)LSEQ * 16 * 8), W_SS3 = AL(W_SS2 + (size_t)MT * 4), W_SSQ = AL(W_SS3 + (size_t)MT * 4), W_BAR = AL(W_SSQ + (size_t)MT * 4), W_XN = AL(W_BAR + 16384),
                 W_FQ = AL(W_XN + (size_t)MTA * D * 2), W_FK = AL(W_FQ + (size_t)MTA * 512 * 2), W_FV = AL(W_FK + (size_t)ER * 512 * 2), W_MISC = AL(W_FV + (size_t)ER * 512 * 2),
                 W_GATES = AL(W_MISC + (size_t)MT * 768 * 4), W_OCAT = AL(W_GATES + (size_t)MT * 2048 * 2), W_END = AL(W_OCAT + (size_t)MTA * 1024 * 2);
constexpr size_t W_CQ = W_OCAT  , W_CKVN = W_XN, W_KR = AL(W_CKVN + (size_t)ER * 256 * 2), W_LOGF = AL(W_KR + (size_t)ER * 32 * 2), W_FB = AL(W_LOGF + (size_t)ER * 8 * 4),
                 W_XN_END = AL(W_FB + (size_t)ER * 8 * 4);
static_assert(W_XN_END <= W_FQ, "XN-region overlay");
constexpr size_t W_MIX = W_XN;
constexpr size_t W_QMLA = W_MISC;
static_assert(W_QMLA + (size_t)MTA * 768 * 2 <= W_GATES, "MISC-region overlay");
constexpr size_t W_H1 = W_GATES, W_H1B = W_MISC, W_G = W_XN;
static_assert(W_G + (size_t)MT * DFF * 2 <= W_MISC, "G overlay");
static_assert((size_t)ER * 1024 * 2 <= (size_t)NB * SEQ * D * 4, "KVMLA lives in the y_prompt region of d_out until the last phase");

#define GAS __attribute__((address_space(1)))
#define LAS __attribute__((address_space(3)))
typedef unsigned short bf16;
typedef unsigned u32x4 __attribute__((ext_vector_type(4)));
typedef unsigned u32x2 __attribute__((ext_vector_type(2)));
typedef float f32x4 __attribute__((ext_vector_type(4)));
typedef float f32x2v __attribute__((ext_vector_type(2)));
typedef float f32x16 __attribute__((ext_vector_type(16)));
typedef short bf16x8 __attribute__((ext_vector_type(8)));
typedef short s16x4 __attribute__((ext_vector_type(4)));
typedef __bf16 bf16x2_t __attribute__((ext_vector_type(2)));
#define LDS_WAIT() asm volatile("s_waitcnt lgkmcnt(0)" ::: "memory")
__device__ __forceinline__ unsigned pk2(float lo, float hi) { f32x2v v = {lo, hi}; bf16x2_t b = __builtin_convertvector(v, bf16x2_t); return __builtin_bit_cast(unsigned, b); }
__device__ __forceinline__ float bflo(unsigned w) { return __uint_as_float(w << 16); }
__device__ __forceinline__ float bfhi(unsigned w) { return __uint_as_float(w & 0xffff0000u); }
__device__ __forceinline__ u32x4 pk8(f32x4 a, f32x4 b) { u32x4 w; w.x = pk2(a[0], a[1]); w.y = pk2(a[2], a[3]); w.z = pk2(b[0], b[1]); w.w = pk2(b[2], b[3]); return w; }
__device__ __forceinline__ float wave_sum(float v) {
#pragma unroll
    for (int o = 1; o < 64; o <<= 1) v += __shfl_xor(v, o);
    return v;
}
__device__ __forceinline__ int ext_row(int m) { return m < MP ? m : MP + ((m - MP) >> 4) * SXR + PAST + ((m - MP) & 15); }
__device__ __forceinline__ int out_row(int m) {
    if (m >= MP) return m < MT ? -1 - (m - MP) : (int)0x80000000;
    const int b = m / LP, tp = m - b * LP;
    return tp >= PADR ? b * LSEQ + (tp - PADR) : (int)0x80000000;
}
__device__ __forceinline__ int pos_of(int m) { if (m >= MP) return PAST + ((m - MP) & 15); const int tp = m % LP; return tp >= PADR ? tp - PADR : 0; }
struct KArgs { const float* in[25]; float* out; unsigned char* ws; };

namespace pg8 {
#define PG8_LAS __attribute__((address_space(3)))
typedef unsigned short bf16_t;
typedef short bf16x8 __attribute__((ext_vector_type(8)));
typedef float f32x4 __attribute__((ext_vector_type(4)));
typedef unsigned u32x4 __attribute__((ext_vector_type(4)));
constexpr int BM = 256, BK = 64, HALF = 128, HTB = HALF * BK * 2  , STAGE_BYTES = 8 * HTB, NXCD = 8, WGM = 8;

__host__ __device__ __forceinline__ int lds_byte(int r, int c) { const int st = (r >> 4) * 2 + (c >> 5), rr = r & 15, cc = c & 31, ob = rr * 64 + cc * 2; return st * 1024 + (ob ^ (((ob >> 9) & 1) << 5)); }
__host__ __device__ __forceinline__ void stage_rc(int b, int& R, int& C) { const int st = b / 1024, sb = b % 1024, swz = sb ^ (((sb >> 9) & 1) << 5); R = (st >> 1) * 16 + swz / 64; C = (st & 1) * 32 + (swz % 64) / 2; }
__host__ __device__ __forceinline__ int perm32(int rho) { const int n = rho >> 4, i = rho & 15; return 8 * (i >> 2) + 4 * n + (i & 3); }

struct Unit { int pm, pn; };
struct Gemm { const bf16_t* A; const bf16_t* Bt; int M, N, K; };

struct StaticOrder {
    int nM, nN, nwg, G, c;
    __host__ __device__ void init(int M, int N, int G_, int c_) { nM = M / BM; nN = N / BM; nwg = nM * nN; G = G_; c = c_; }
    __host__ __device__ bool next(int i, Unit& u) const {
        const long L = (long)i * G + c; if (L >= nwg) return false;
        int wgid = (int)L; { const int q = nwg / NXCD, r = nwg % NXCD, xcd = wgid % NXCD, off = wgid / NXCD; wgid = (xcd < r ? xcd * (q + 1) : r * (q + 1) + (xcd - r) * q) + off; }
        const int nig = WGM * nN, gid = wgid / nig, fm = gid * WGM, gsz = (nM - fm) < WGM ? (nM - fm) : WGM;
        u.pm = fm + ((wgid % nig) % gsz); u.pn = (wgid % nig) / gsz; return true;
    }
    __device__ __forceinline__ void a_ready(const Unit&) const {}
    __device__ __forceinline__ void done(const Unit&) const {}
};


struct AMap { int perm, wrs, trows; };
#define PG8_ROW(ai, m) (u.pm * BM + (ai) * HALF + wr * 64 + (m) * 16 + fr)
#define PG8_EACH_AM _Pragma("unroll") for (int ai = 0; ai < 2; ++ai) _Pragma("unroll") for (int m = 0; m < 4; ++m)
#define PG8_RELANE do { int t_ = threadIdx.x; asm volatile("" : "+v"(t_)); fr = t_ & 15; fq = (t_ >> 4) & 3; const int w_ = __builtin_amdgcn_readfirstlane(t_ >> 6); wr = w_ >> 2; wc = w_ & 3; } while (0)
#define PG8_EACH_BJ _Pragma("unroll") for (int bj = 0; bj < 2; ++bj)
__device__ __forceinline__ f32x4 sig4(f32x4 x) { f32x4 r;
#pragma unroll
    for (int i = 0; i < 4; ++i) r[i] = __builtin_amdgcn_rcpf(1.f + __expf(-x[i])); return r; }
__device__ __forceinline__ f32x4 unlo(u32x2 w) { return (f32x4){::bflo(w.x), ::bfhi(w.x), ::bflo(w.y), ::bfhi(w.y)}; }
__device__ __forceinline__ float dpp_shr1(float v) { return __builtin_bit_cast(float, __builtin_amdgcn_update_dpp(0, __builtin_bit_cast(int, v), 0x111, 0xF, 0xF, false)); }

struct EpiPlain {
    static constexpr bool PERM = true, AFTER_DRAIN = false, MIDHOOK = false, PROBE2 = false;
    bf16_t* O; int ldc;
    __device__ __forceinline__ void operator()(const f32x4 (&acc)[2][2][4][2], const Unit& u, int wr, int wc, int fr, int fq) const { PG8_RELANE;
        const int colb = u.pn * BM + wc * 32 + 8 * fq;
        PG8_EACH_AM { bf16_t* p = O + (size_t)PG8_ROW(ai, m) * ldc + colb;
            PG8_EACH_BJ *(u32x4*)(p + bj * HALF) = ::pk8(acc[ai][bj][m][0], acc[ai][bj][m][1]); }
    }
};
struct EpiWin {
    static constexpr bool PERM = true, AFTER_DRAIN = false, MIDHOOK = false, PROBE2 = false;
    bf16_t *FQ, *FK, *FV, *GATES; float* MISC; float* out; bf16_t* CQ; float* SSQ;
    __device__ __forceinline__ void operator()(const f32x4 (&acc)[2][2][4][2], const Unit& u, int wr, int wc, int fr, int fq) const { PG8_RELANE;
        const int pn = u.pn, cw = wc * 32 + 8 * fq;
        PG8_EACH_AM { const int row = PG8_ROW(ai, m);
            if (pn < 2) { bf16_t* p = FQ + (size_t)row * 512 + pn * 256 + cw;
                PG8_EACH_BJ *(u32x4*)(p + bj * HALF) = ::pk8(acc[ai][bj][m][0] * (0.125f * LOG2E), acc[ai][bj][m][1] * (0.125f * LOG2E)); }
            else if (pn < 6) { const int which = (pn - 2) >> 1, c = ((pn - 2) & 1) * 256 + cw; const int er = ::ext_row(row), orow = ::out_row(row);
                bf16_t* p = (which ? FV : FK) + (size_t)er * 512 + c; float* o = nullptr;
                if (orow < 0 && orow != (int)0x80000000) o = out + (which ? O_VS : O_KS) + (size_t)(-1 - orow) * 512 + c;
                PG8_EACH_BJ { *(u32x4*)(p + bj * HALF) = ::pk8(acc[ai][bj][m][0], acc[ai][bj][m][1]);
                    if (o) { *(f32x4*)(o + bj * HALF) = acc[ai][bj][m][0]; *(f32x4*)(o + bj * HALF + 4) = acc[ai][bj][m][1]; } } }
            else if (pn < 9) { float* p = MISC + (size_t)row * 768 + (pn - 6) * 256 + cw; float ss = 0.f;
                PG8_EACH_BJ { const f32x4 a = acc[ai][bj][m][0], b = acc[ai][bj][m][1];
                    if (pn == 6 || (pn == 7 && bj == 0)) { *(u32x4*)(CQ + (size_t)row * 384 + (pn - 6) * 256 + bj * HALF + cw) = ::pk8(a, b);
                        ss += (a[0] * a[0] + a[1] * a[1]) + (a[2] * a[2] + a[3] * a[3]) + (b[0] * b[0] + b[1] * b[1]) + (b[2] * b[2] + b[3] * b[3]); }
                    else { *(f32x4*)(p + bj * HALF) = a; *(f32x4*)(p + bj * HALF + 4) = b; } }
                if (pn < 8) { ss += __shfl_xor(ss, 16); ss += __shfl_xor(ss, 32); if (fq == 0) unsafeAtomicAdd(SSQ + row, ss); } }
            else { bf16_t* p = GATES + (size_t)row * 2048 + (pn - 9) * 256 + cw;
                PG8_EACH_BJ *(u32x4*)(p + bj * HALF) = ::pk8(sig4(acc[ai][bj][m][0]), sig4(acc[ai][bj][m][1])); }
            asm volatile("" ::: "memory");
        }
    }
};
struct EpiQ {
    static constexpr bool PERM = true, AFTER_DRAIN = false, MIDHOOK = false, PROBE2 = false;
    bf16_t* Q; const float* rope; const float* ssq;
    __device__ __forceinline__ void operator()(const f32x4 (&acc)[2][2][4][2], const Unit& u, int wr, int wc, int fr, int fq) const { PG8_RELANE;
        PG8_EACH_BJ { const int g32 = u.pn * 8 + bj * 4 + wc; const bool rp = (g32 % 3) == 2; const float sg = (fq < 2) ? -1.f : 1.f;
            PG8_EACH_AM { const int row = PG8_ROW(ai, m); const float rq = __builtin_amdgcn_rsqf(ssq[row] * (1.f / 384.f) + EPS) * (0.10206207261596575f * LOG2E);
                f32x4 v0 = acc[ai][bj][m][0] * rq, v1 = acc[ai][bj][m][1] * rq;
                if (rp) { const float* t = rope + ((size_t)::pos_of(row) * 16 + 8 * (fq & 1)) * 2;
                    const f32x4 t0 = *(const f32x4*)t, t1 = *(const f32x4*)(t + 4), t2 = *(const f32x4*)(t + 8), t3 = *(const f32x4*)(t + 12);
                    f32x4 q0, q1;
#pragma unroll
                    for (int i = 0; i < 4; ++i) { q0[i] = __shfl_xor(v0[i], 32); q1[i] = __shfl_xor(v1[i], 32); }
                    v0[0] = v0[0] * t0[0] + sg * q0[0] * t0[1]; v0[1] = v0[1] * t0[2] + sg * q0[1] * t0[3]; v0[2] = v0[2] * t1[0] + sg * q0[2] * t1[1]; v0[3] = v0[3] * t1[2] + sg * q0[3] * t1[3];
                    v1[0] = v1[0] * t2[0] + sg * q1[0] * t2[1]; v1[1] = v1[1] * t2[2] + sg * q1[1] * t2[3]; v1[2] = v1[2] * t3[0] + sg * q1[2] * t3[1]; v1[3] = v1[3] * t3[2] + sg * q1[3] * t3[3]; }
                *(u32x4*)(Q + (size_t)row * 768 + u.pn * BM + bj * HALF + wc * 32 + 8 * fq) = ::pk8(v0, v1); asm volatile("" ::: "memory"); } }
    }
};
struct EpiMixCat {
    static constexpr bool PERM = true, AFTER_DRAIN = false, MIDHOOK = true, PROBE2 = false;
    bf16_t* MIX; const bf16_t* GATES;
    __device__ __forceinline__ void mid(f32x4 (&acc)[2][2][4][2], const Unit& u, int wr, int wc, int fr, int fq) const { PG8_RELANE;
        const int colb = u.pn * BM + wc * 32 + 8 * fq;
        PG8_EACH_AM { const int row = PG8_ROW(ai, m);
            PG8_EACH_BJ { const bf16_t* gp = GATES + (size_t)row * 2048 + colb + bj * HALF; const u32x4 ga = *(const u32x4*)gp, gb = *(const u32x4*)(gp + 1024);
                f32x4 a0 = unlo((u32x2){ga.x, ga.y}), a1 = unlo((u32x2){ga.z, ga.w}), b0 = unlo((u32x2){gb.x, gb.y}), b1 = unlo((u32x2){gb.z, gb.w});
#pragma unroll
                for (int i = 0; i < 4; ++i) { a0[i] *= __builtin_amdgcn_rcpf(fmaxf(b0[i], 1e-30f)); a1[i] *= __builtin_amdgcn_rcpf(fmaxf(b1[i], 1e-30f)); }
                acc[ai][bj][m][0] *= a0; acc[ai][bj][m][1] *= a1; }
            asm volatile("" ::: "memory"); }
    }
    __device__ __forceinline__ void operator()(const f32x4 (&acc)[2][2][4][2], const Unit& u, int wr, int wc, int fr, int fq) const { PG8_RELANE;
        const int colb = u.pn * BM + wc * 32 + 8 * fq;
        PG8_EACH_AM { const int row = PG8_ROW(ai, m);
            PG8_EACH_BJ { const int col = colb + bj * HALF; const u32x4 gb = *(const u32x4*)(GATES + (size_t)row * 2048 + 1024 + col);
                f32x4 b0 = unlo((u32x2){gb.x, gb.y}), b1 = unlo((u32x2){gb.z, gb.w});
#pragma unroll
                for (int i = 0; i < 4; ++i) { b0[i] = fmaxf(b0[i], 1e-30f); b1[i] = fmaxf(b1[i], 1e-30f); }
                *(u32x4*)(MIX + (size_t)row * 1024 + col) = ::pk8(acc[ai][bj][m][0] * b0, acc[ai][bj][m][1] * b1); } }
    }
};
struct EpiH1 {
    static constexpr bool PERM = true, AFTER_DRAIN = false, MIDHOOK = false, PROBE2 = false;
    const float *xp, *meta, *xs; float* H1; bf16_t* H1B; float* SS;
    __device__ __forceinline__ void operator()(const f32x4 (&acc)[2][2][4][2], const Unit& u, int wr, int wc, int fr, int fq) const { PG8_RELANE;
        const int colb = u.pn * BM + wc * 32 + 8 * fq;
        PG8_EACH_AM { const int row = PG8_ROW(ai, m); const float* xr = nullptr;
            if (row >= MP) xr = xs + (size_t)(row - MP) * D; else { const int b = row / LP, tp = row - b * LP; if (tp >= 64) xr = xp + ((size_t)b * SEQ + (tp - 64)) * D; else if (tp >= PADR) xr = meta + (size_t)(tp - PADR) * D; }
            float ss = 0.f;
            PG8_EACH_BJ { const int col = colb + bj * HALF; f32x4 a = acc[ai][bj][m][0], b = acc[ai][bj][m][1];
                if (xr) { a += *(const f32x4*)(xr + col); b += *(const f32x4*)(xr + col + 4); }
                *(u32x4*)(H1B + (size_t)row * D + col) = ::pk8(a, b);
                ss += (a[0] * a[0] + a[1] * a[1]) + (a[2] * a[2] + a[3] * a[3]) + (b[0] * b[0] + b[1] * b[1]) + (b[2] * b[2] + b[3] * b[3]); }
            ss += __shfl_xor(ss, 16); ss += __shfl_xor(ss, 32);
            if (fq == 0) unsafeAtomicAdd(SS + row, ss); }
    }
};
struct EpiH2 {
    static constexpr bool PERM = true, AFTER_DRAIN = false, MIDHOOK = false, PROBE2 = false;
    bf16_t* HB; float* SS;
    __device__ __forceinline__ void operator()(const f32x4 (&acc)[2][2][4][2], const Unit& u, int wr, int wc, int fr, int fq) const { PG8_RELANE;
        const int colb = u.pn * BM + wc * 32 + 8 * fq;
        PG8_EACH_AM { const int row = PG8_ROW(ai, m); float ss = 0.f;
            PG8_EACH_BJ { bf16_t* p = HB + (size_t)row * D + colb + bj * HALF; const u32x4 o = *(const u32x4*)p;
                const f32x4 a = acc[ai][bj][m][0] + unlo((u32x2){o.x, o.y}), b = acc[ai][bj][m][1] + unlo((u32x2){o.z, o.w});
                *(u32x4*)p = ::pk8(a, b);
                ss += (a[0] * a[0] + a[1] * a[1]) + (a[2] * a[2] + a[3] * a[3]) + (b[0] * b[0] + b[1] * b[1]) + (b[2] * b[2] + b[3] * b[3]); }
            ss += __shfl_xor(ss, 16); ss += __shfl_xor(ss, 32);
            if (fq == 0) unsafeAtomicAdd(SS + row, ss); }
    }
};
template <bool SAMPLE> struct EpiConv {
    static constexpr bool PERM = true, AFTER_DRAIN = false, MIDHOOK = false, PROBE2 = true;
    bf16_t* G; const float* ss2; const float* convw; const float* convb; const float* state; float* out; int wrs;
    __device__ __forceinline__ void operator()(const f32x4 (&acc)[2][2][4][2], const Unit& u, int wr, int wc, int fr, int fq) const { PG8_RELANE;
        const int runbase = (SAMPLE ? MP : u.pm * 252) + wrs * wr, base = runbase + 8 * fr;
        float rs[8]; unsigned okm = 0u;
#pragma unroll
        for (int j = 0; j < 8; ++j) { const int tok = base + j;
            if (SAMPLE) { rs[j] = __builtin_amdgcn_rsqf(ss2[tok] * (1.f / D) + EPS); okm |= 1u << j; }
            else { const int tc = tok < MT ? tok : MT - 1; const bool v = tok < MP && (tc % LP) >= PADR; rs[j] = v ? __builtin_amdgcn_rsqf(ss2[tc] * (1.f / D) + EPS) : 0.f;
                if (tok < MP && (fr > 0 || j >= 2)) okm |= 1u << j; } }
        const int chb = u.pn * 128 + wc * 32 + 8 * fq;
        const int sb = 8 * wr + (fr >> 1);
        int eb = -1, etok = 0;
        if (!SAMPLE) { const int b = runbase / LP; etok = b * LP + LP - 2; if (b < NB && etok < runbase + 128) eb = b; }
        unsigned char* gb = (unsigned char*)G + (size_t)(unsigned)base * (DFF * 2);
#pragma unroll
        for (int n = 0; n < 2; ++n) { const int ch = chb + 4 * n; f32x4 cg[8];
#pragma unroll
            for (int bj = 0; bj < 2; ++bj) { const int cx = bj * DFF + ch;
                const f32x4 cb = *(const f32x4*)(convb + cx), w0 = *(const f32x4*)(convw + cx), w1 = *(const f32x4*)(convw + UPW + cx), w2 = *(const f32x4*)(convw + 2 * UPW + cx);
                f32x4 p1, p2;
                { const f32x4 u7 = acc[1][bj][3][n] * rs[7], u6 = acc[1][bj][2][n] * rs[6];
#pragma unroll
                    for (int e2 = 0; e2 < 4; ++e2) { p1[e2] = dpp_shr1(u7[e2]); p2[e2] = dpp_shr1(u6[e2]); }
                    if (SAMPLE) { if (fr & 1) { *(f32x4*)(out + O_CVS + ((size_t)sb * 2) * UPW + cx) = u6; *(f32x4*)(out + O_CVS + ((size_t)sb * 2 + 1) * UPW + cx) = u7; }
                        else { p1 = *(const f32x4*)(state + ((size_t)sb * 2 + 1) * UPW + cx); p2 = *(const f32x4*)(state + ((size_t)sb * 2) * UPW + cx); } } }
                if (!SAMPLE && eb >= 0) {
#pragma unroll
                    for (int j = 0; j < 8; ++j) { const int k = base + j - etok; if ((k == 0 || k == 1) && ((okm >> j) & 1u)) *(f32x4*)(out + O_CVP + ((size_t)eb * 2 + k) * UPW + cx) = acc[j >> 2][bj][j & 3][n] * rs[j]; } }
                f32x4 um2 = p2, um1 = p1;
#pragma unroll
                for (int j = 0; j < 8; ++j) { const f32x4 uj = acc[j >> 2][bj][j & 3][n] * rs[j];
                    const f32x4 c = cb + w0 * um2 + w1 * um1 + w2 * uj; um2 = um1; um1 = uj;
                    if (bj == 0) cg[j] = c;
                    else { const f32x4 o = cg[j] * sig4(cg[j]) * c;
                        if ((okm >> j) & 1u) *(u32x2*)(gb + j * (DFF * 2) + ch * 2) = (u32x2){::pk2(o[0], o[1]), ::pk2(o[2], o[3])}; } }
                asm volatile("" ::: "memory");
            } }
    }
};
template <class Epi, class Sched, bool ALIGN_EPI = false, bool SP2 = false>
__device__ __forceinline__ void gemm_phase(PG8_LAS unsigned char* lds, const Gemm g, const Sched& S, const Epi& E, const AMap am) {
    int tid_ = threadIdx.x; asm volatile("" : "+v"(tid_));
    const int tid = tid_, wid = __builtin_amdgcn_readfirstlane(tid >> 6), lane = tid & 63, wr = wid >> 2, wc = wid & 3, fr = lane & 15, fq = lane >> 4;
    int K_ = g.K; asm volatile("" : "+s"(K_)); const int K = K_, nt = K / BK;
    unsigned voffA[2], voffB[2];
#pragma unroll
    for (int i = 0; i < 2; ++i) { int R, C; stage_rc(tid * 16 + i * 8192, R, C); const int Rb = Epi::PERM ? ((R & ~31) + perm32(R & 31)) : R;
        voffA[i] = (unsigned)((am.perm ? (am.wrs * (R >> 6) + 8 * (R & 15) + ((R >> 4) & 3)) : R) * K + C) * 2u; voffB[i] = (unsigned)(Rb * K + C) * 2u; }
    const size_t kstep = (size_t)(BK * 2);
    const size_t hstep = (size_t)HALF * K * 2;
    const size_t tstep = 2 * hstep;
    const size_t hstepA = am.perm ? (size_t)4 * K * 2 : hstep; const size_t tstepA = (size_t)am.trows * K * 2;
    const unsigned ldsw = (unsigned)wid * 1024u;
    const int aoff = lds_byte(wr * 64 + fr, fq * 8), boff = lds_byte(wc * 32 + fr, fq * 8);
#define PG8_SA(b, h) (((b) * 2 + (h)) * HTB)
#define PG8_SB(b, h) ((4 + (b) * 2 + (h)) * HTB)
#define PG8_STAGE(bufoff, gbase, voff) do { _Pragma("unroll") for (int _i = 0; _i < 2; ++_i) \
        __builtin_amdgcn_global_load_lds((const unsigned*)((const char*)(gbase) + (voff)[_i]), (PG8_LAS unsigned*)(lds + (bufoff) + ldsw + _i * 8192), 16, 0, 0); } while (0)
#define PG8_LDA(dst, b, h) do { _Pragma("unroll") for (int m = 0; m < 4; ++m) _Pragma("unroll") for (int k = 0; k < 2; ++k) dst[m][k] = *(const PG8_LAS bf16x8*)(lds + PG8_SA(b, h) + aoff + m * 2048 + k * 1024); } while (0)
#define PG8_LDB(dst, b, h) do { _Pragma("unroll") for (int n = 0; n < 2; ++n) _Pragma("unroll") for (int k = 0; k < 2; ++k) dst[n][k] = *(const PG8_LAS bf16x8*)(lds + PG8_SB(b, h) + boff + n * 2048 + k * 1024); } while (0)
#define PG8_MMA(ai, bj, At, Bt) do { __builtin_amdgcn_s_setprio(1); _Pragma("unroll") for (int m = 0; m < 4; ++m) _Pragma("unroll") for (int n = 0; n < 2; ++n) _Pragma("unroll") for (int k = 0; k < 2; ++k) \
        acc[ai][bj][m][n] = __builtin_amdgcn_mfma_f32_16x16x32_bf16(Bt[n][k], At[m][k], acc[ai][bj][m][n], 0, 0, 0); __builtin_amdgcn_s_setprio(0); } while (0)
#define PG8_WAIT_V(n) asm volatile("s_waitcnt vmcnt(" #n ")" ::: "memory")
#define PG8_WAIT_L(n) asm volatile("s_waitcnt lgkmcnt(" #n ")" ::: "memory")
#define PG8_BAR __builtin_amdgcn_s_barrier()
#define PG8_SCHED __builtin_amdgcn_sched_barrier(0)
    Unit cur, nxt; int ui = 0;
    if (!S.next(0, cur)) return;
    f32x4 acc[2][2][4][2];
#pragma unroll
    for (int a = 0; a < 2; ++a)
#pragma unroll
        for (int b = 0; b < 2; ++b)
#pragma unroll
            for (int m = 0; m < 4; ++m)
#pragma unroll
                for (int n = 0; n < 2; ++n) acc[a][b][m][n] = (f32x4){0.f, 0.f, 0.f, 0.f};
    bf16x8 At[4][2], B0[2][2], B1[2][2];
    const char* cA = (const char*)g.A + (size_t)cur.pm * tstepA; const char* cB = (const char*)g.Bt + (size_t)cur.pn * tstep;
    S.a_ready(cur);
    if constexpr (SP2) {
        PG8_STAGE(PG8_SB(0, 0), cB, voffB); PG8_STAGE(PG8_SB(0, 1), cB + hstep, voffB); PG8_STAGE(PG8_SA(0, 0), cA, voffA); PG8_STAGE(PG8_SA(0, 1), cA + hstepA, voffA);
        if (wr == 1) PG8_BAR;
        PG8_WAIT_V(2); PG8_BAR;
        PG8_STAGE(PG8_SB(1, 0), cB + kstep, voffB); PG8_STAGE(PG8_SA(1, 0), cA + kstep, voffA); PG8_STAGE(PG8_SB(1, 1), cB + hstep + kstep, voffB);
        PG8_WAIT_V(6); PG8_BAR;
    } else {
        PG8_STAGE(PG8_SB(0, 0), cB, voffB); PG8_STAGE(PG8_SA(0, 0), cA, voffA); PG8_STAGE(PG8_SB(0, 1), cB + hstep, voffB); PG8_STAGE(PG8_SA(0, 1), cA + hstepA, voffA);
        if (wr == 1) PG8_BAR;
        PG8_WAIT_V(4); PG8_BAR;
        PG8_STAGE(PG8_SB(1, 0), cB + kstep, voffB); PG8_STAGE(PG8_SA(1, 0), cA + kstep, voffA); PG8_STAGE(PG8_SB(1, 1), cB + hstep + kstep, voffB);
        PG8_WAIT_V(6); PG8_BAR;
    }
    for (;;) {
        const bool has_next = S.next(ui + 1, nxt);
        const char* nA = has_next ? (const char*)g.A + (size_t)nxt.pm * tstepA : cA; const char* nB = has_next ? (const char*)g.Bt + (size_t)nxt.pn * tstep : cB;
        for (int t = 0; t < nt; t += 2) {
            const bool last = (t == nt - 2);
            const char* a1 = cA + (size_t)(t + 1) * kstep;
            const char* a2 = last ? nA : cA + (size_t)(t + 2) * kstep; const char* b2 = last ? nB : cB + (size_t)(t + 2) * kstep;
            const char* a3 = a2 + kstep; const char* b3 = b2 + kstep;
            if (last && has_next) S.a_ready(nxt);
            if constexpr (SP2) {
            PG8_LDB(B0, 0, 0); PG8_LDB(B1, 0, 1); PG8_SCHED; PG8_LDA(At, 0, 0); PG8_STAGE(PG8_SA(1, 1), a1 + hstepA, voffA);
            PG8_WAIT_V(8); PG8_WAIT_L(0); PG8_BAR; PG8_MMA(0, 0, At, B0); PG8_MMA(0, 1, At, B1); PG8_BAR; PG8_SCHED;
            PG8_LDA(At, 0, 1); PG8_STAGE(PG8_SB(0, 0), b2, voffB); PG8_STAGE(PG8_SB(0, 1), b2 + hstep, voffB); PG8_STAGE(PG8_SA(0, 0), a2, voffA);
            PG8_WAIT_V(8); PG8_WAIT_L(0); PG8_BAR; PG8_MMA(1, 0, At, B0); PG8_MMA(1, 1, At, B1); PG8_BAR; PG8_SCHED;
            PG8_LDB(B0, 1, 0); PG8_LDB(B1, 1, 1); PG8_SCHED; PG8_LDA(At, 1, 0); PG8_STAGE(PG8_SA(0, 1), a2 + hstepA, voffA);
            PG8_WAIT_V(8); PG8_WAIT_L(0); PG8_BAR; PG8_MMA(0, 0, At, B0); PG8_MMA(0, 1, At, B1); PG8_BAR; PG8_SCHED;
            PG8_LDA(At, 1, 1); PG8_STAGE(PG8_SB(1, 0), b3, voffB); PG8_STAGE(PG8_SB(1, 1), b3 + hstep, voffB); PG8_STAGE(PG8_SA(1, 0), a3, voffA);
            PG8_WAIT_V(8); PG8_WAIT_L(0); PG8_BAR; PG8_MMA(1, 0, At, B0); PG8_MMA(1, 1, At, B1); PG8_BAR; PG8_SCHED;
            if constexpr (Epi::MIDHOOK) { if (t + 2 == nt / 2) E.mid(acc, cur, wr, wc, fr, fq); }
            } else {
            PG8_LDB(B0, 0, 0); PG8_SCHED; PG8_LDA(At, 0, 0); PG8_STAGE(PG8_SA(1, 1), a1 + hstepA, voffA);
            PG8_WAIT_L(8); PG8_BAR; PG8_WAIT_L(0); PG8_MMA(0, 0, At, B0); PG8_BAR; PG8_SCHED;
            PG8_LDB(B1, 0, 1); PG8_STAGE(PG8_SB(0, 0), b2, voffB);
            PG8_BAR; PG8_WAIT_L(0); PG8_MMA(0, 1, At, B1); PG8_BAR;
            PG8_LDA(At, 0, 1); PG8_STAGE(PG8_SA(0, 0), a2, voffA);
            PG8_BAR; PG8_WAIT_L(0); PG8_MMA(1, 0, At, B0); PG8_BAR; PG8_SCHED;
            PG8_STAGE(PG8_SB(0, 1), b2 + hstep, voffB);
            PG8_WAIT_V(6); PG8_BAR; PG8_MMA(1, 1, At, B1); PG8_BAR;
            PG8_LDB(B0, 1, 0); PG8_SCHED; PG8_LDA(At, 1, 0); PG8_STAGE(PG8_SA(0, 1), a2 + hstepA, voffA);
            PG8_WAIT_L(8); PG8_BAR; PG8_WAIT_L(0); PG8_MMA(0, 0, At, B0); PG8_BAR; PG8_SCHED;
            PG8_LDB(B1, 1, 1); PG8_STAGE(PG8_SB(1, 0), b3, voffB);
            PG8_BAR; PG8_WAIT_L(0); PG8_MMA(0, 1, At, B1); PG8_BAR;
            PG8_LDA(At, 1, 1); PG8_STAGE(PG8_SA(1, 0), a3, voffA);
            PG8_BAR; PG8_WAIT_L(0); PG8_MMA(1, 0, At, B0); PG8_BAR; PG8_SCHED;
            PG8_STAGE(PG8_SB(1, 1), b3 + hstep, voffB);
            PG8_WAIT_V(6); PG8_BAR; PG8_MMA(1, 1, At, B1); PG8_BAR;
            }
        }
        if constexpr (ALIGN_EPI) { if (wr == 0) PG8_BAR; }
        if constexpr (!Epi::AFTER_DRAIN) { E(acc, cur, wr, wc, fr, fq);
#ifdef PROBE_EPI2
            if constexpr (Epi::PROBE2) { asm volatile("" ::: "memory"); E(acc, cur, wr, wc, fr, fq); }
#endif
            S.done(cur); }
        if (!has_next) break;
#pragma unroll
        for (int a = 0; a < 2; ++a)
#pragma unroll
            for (int b = 0; b < 2; ++b)
#pragma unroll
                for (int m = 0; m < 4; ++m)
#pragma unroll
                    for (int n = 0; n < 2; ++n) acc[a][b][m][n] = (f32x4){0.f, 0.f, 0.f, 0.f};
        cur = nxt; cA = nA; cB = nB; ++ui;
        if constexpr (ALIGN_EPI) { if (wr == 1) PG8_BAR; }
    }
    PG8_WAIT_V(0);
    if constexpr (!ALIGN_EPI) { if (wr == 0) PG8_BAR; }
    PG8_BAR;
    if constexpr (Epi::AFTER_DRAIN) { E.fused(acc, cur, wr, wc, fr, fq, lds, wid, lane); S.done(cur); }
#undef PG8_SA
#undef PG8_SB
#undef PG8_STAGE
#undef PG8_LDA
#undef PG8_LDB
#undef PG8_MMA
#undef PG8_WAIT_V
#undef PG8_WAIT_L
#undef PG8_BAR
#undef PG8_SCHED
}
}

__device__ __forceinline__ void tr_item(const float* W, int Nsrc, int K, bf16* WT, int drow0, int scol0, int nvalid, const float* kscale, LAS float* scr, int kb, int lane, int koff = 0) {
    const int k0 = 64 * kb;
#pragma unroll 16
    for (int i = 0; i < 32; ++i) { const int kk = 2 * i + (lane >> 5), c = lane & 31; float v = 0.f;
        if (c < nvalid) v = W[(size_t)(k0 + kk) * Nsrc + scol0 + c];
        if (kscale) v *= kscale[k0 + kk];
        scr[kk * 33 + c] = v; }
    LDS_WAIT(); asm volatile("" ::: "memory");
    const int c8 = lane & 7;
#pragma unroll
    for (int j = 0; j < 4; ++j) { const int n = (lane >> 3) + 8 * j; const LAS float* s = scr + (8 * c8) * 33 + n;
        u32x4 o; o.x = pk2(s[0 * 33], s[1 * 33]); o.y = pk2(s[2 * 33], s[3 * 33]); o.z = pk2(s[4 * 33], s[5 * 33]); o.w = pk2(s[6 * 33], s[7 * 33]);
        *(u32x4*)(WT + (size_t)(drow0 + n) * K + koff + k0 + 8 * c8) = o; }
    LDS_WAIT(); asm volatile("" ::: "memory");
}
__device__ __forceinline__ const float* x_row_ptr(int m, const float* xp, const float* meta, const float* xs) {
    if (m >= MP) return xs + (size_t)(m - MP) * D;
    const int b = m / LP, tp = m - b * LP;
    if (tp >= 64) return xp + ((size_t)b * SEQ + (tp - 64)) * D;
    if (tp >= PADR) return meta + (size_t)(tp - PADR) * D;
    return nullptr;
}
__device__ __forceinline__ void p0_prologue(const KArgs& a, LAS unsigned char* lds, int gw, int NGW, int wave, int lane, int gtid, int NT) {
    unsigned char* ws = a.ws;
    LAS float* scr = (LAS float*)(lds + wave * 16384);
    constexpr int I0 = 16 * 136, I1 = I0 + 6 * 24, I2 = I1 + 4 * 32, I3 = I2 + 8 * 32, I4 = I3 + 8 * 32, I5 = I4 + 16 * 32, I6 = I5 + 16 * 176, I7 = I6 + 44 * 32;
    for (int it = gw; it < I7; it += NGW) {
        if (it < I0) { const int kb = it / 136, g = it % 136, n0 = 32 * g; int sc, nv = 32;
            if (n0 < 1536) sc = n0;
            else if (n0 < 2304) { const int j = n0 - 1536; if (j < 384) sc = OFF_CQ + j; else if (j == 384) sc = OFF_KR; else if (j == 416) { sc = OFF_FF; nv = 8; } else if (j < 512) { sc = 0; nv = 0; } else sc = OFF_CKV + (j - 512); }
            else sc = OFF_GATE + (n0 - 2304);
            tr_item(a.in[10], INW, D, (bf16*)(ws + W_WIN), n0, sc, nv, nullptr, scr, kb, lane); }
        else if (it < I1) { const int r = it - I0, kb = r / 24, g = r % 24; tr_item(a.in[13], 768, 384, (bf16*)(ws + W_WUQ), 32 * g, 32 * g, 32, a.in[12], scr, kb, lane); }
        else if (it < I2) { const int r = it - I1, kb = r / 32, g = r % 32; tr_item(a.in[15], 1024, 256, (bf16*)(ws + W_WUKV), 32 * g, 32 * g, 32, nullptr, scr, kb, lane); }
        else if (it < I3) { const int r = it - I2, kb = r / 32, g = r % 32; tr_item(a.in[16], 1024, 1024, (bf16*)(ws + W_WOC), 32 * g, 32 * g, 32, nullptr, scr, kb, lane, 0); }
        else if (it < I4) { const int r = it - I3, kb = r / 32, g = r % 32; tr_item(a.in[17], 1024, 1024, (bf16*)(ws + W_WOC), 32 * g, 32 * g, 32, nullptr, scr, kb, lane, 512); }
        else if (it < I5) { const int r = it - I4, kb = r / 32, g = r % 32; tr_item(a.in[18], 1024, 1024, (bf16*)(ws + W_WOUT), 32 * g, 32 * g, 32, nullptr, scr, kb, lane); }
        else if (it < I6) { const int r = it - I5, kb = r / 176, g = r % 176, n0 = 32 * g, pn = n0 >> 8, jj = n0 & 255, bj = jj >> 7, ch = 128 * pn + (jj & 127);
            tr_item(a.in[20], UPW, D, (bf16*)(ws + W_WUP), n0, bj * DFF + ch, 32, a.in[19], scr, kb, lane); }
        else { const int r = it - I6, kb = r / 32, g = r % 32; tr_item(a.in[23], 1024, DFF, (bf16*)(ws + W_WDN), 32 * g, 32 * g, 32, nullptr, scr, kb, lane); }
    }
    { const float* gm = a.in[9]; f32x4 gv[4];
#pragma unroll
        for (int j = 0; j < 4; ++j) gv[j] = *(const f32x4*)(gm + 4 * lane + 256 * j);
        bf16* XN = (bf16*)(ws + W_XN);
        for (int m0 = 4 * gw; m0 < MT; m0 += 4 * NGW) {
            f32x4 v[4][4]; float s[4];
#pragma unroll
            for (int q = 0; q < 4; ++q) { const float* xr = x_row_ptr(m0 + q, a.in[0], a.in[8], a.in[1]);
#pragma unroll
                for (int j = 0; j < 4; ++j) v[q][j] = xr ? *(const f32x4*)(xr + 4 * lane + 256 * j) : (f32x4){0.f, 0.f, 0.f, 0.f}; }
#pragma unroll
            for (int q = 0; q < 4; ++q) { s[q] = 0.f;
#pragma unroll
                for (int j = 0; j < 4; ++j) s[q] += (v[q][j][0] * v[q][j][0] + v[q][j][1] * v[q][j][1]) + (v[q][j][2] * v[q][j][2] + v[q][j][3] * v[q][j][3]); }
#pragma unroll
            for (int q = 0; q < 4; ++q) { const float r = __builtin_amdgcn_rsqf(wave_sum(s[q]) * (1.f / D) + EPS);
#pragma unroll
                for (int j = 0; j < 4; ++j) { const f32x4 o = v[q][j] * r * gv[j]; *(u32x2*)(XN + (size_t)(m0 + q) * D + 4 * lane + 256 * j) = (u32x2){pk2(o[0], o[1]), pk2(o[2], o[3])}; } } } }
    { bf16* FK = (bf16*)(ws + W_FK); bf16* FV = (bf16*)(ws + W_FV);
        for (int t0 = gw; t0 < SB * SXR; t0 += 2 * NGW) {
            u32x4 k[2], v[2]; bool wr_[2];
#pragma unroll
            for (int q = 0; q < 2; ++q) { const int t = t0 + q * NGW; k[q] = (u32x4){0u, 0u, 0u, 0u}; v[q] = k[q]; wr_[q] = false;
                if (t < SB * SXR) { const int sb = t / SXR, j = t - sb * SXR; wr_[q] = !(j >= PAST && j < PAST + SN);
                    if (j < PAST) { const size_t src = ((size_t)sb * PAST + j) * 512 + 8 * lane; k[q] = pk8(*(const f32x4*)(a.in[2] + src), *(const f32x4*)(a.in[2] + src + 4)); v[q] = pk8(*(const f32x4*)(a.in[3] + src), *(const f32x4*)(a.in[3] + src + 4)); } } }
#pragma unroll
            for (int q = 0; q < 2; ++q) if (wr_[q]) { const size_t er = (size_t)(MP + t0 + q * NGW) * 512 + 8 * lane; *(u32x4*)(FK + er) = k[q]; *(u32x4*)(FV + er) = v[q]; } } }
    { float* s2 = (float*)(ws + W_SS2); float* s3 = (float*)(ws + W_SS3); float* sq = (float*)(ws + W_SSQ); for (int i = gtid; i < MT; i += NT) { s2[i] = 0.f; s3[i] = 0.f; sq[i] = 0.f; }
        float* rp = (float*)(ws + W_ROPE);
        for (int i = gtid; i < LSEQ * 16; i += NT) { const int pos = i >> 4, k = i & 15; const float inv = exp2f(-(float)k * (13.287712379549449f / 16.f)); const float ang = (float)pos * inv;
            const double rev = (double)ang * 0.15915494309189535; const double fr = rev - __builtin_rint(rev); const float f = (float)fr;
            rp[2 * i] = __builtin_amdgcn_cosf(f); rp[2 * i + 1] = __builtin_amdgcn_sinf(f); } }
}
__device__ __forceinline__ void p2_fixup(const KArgs& a, int gw, int NGW, int lane) {
    unsigned char* ws = a.ws; const float* MISC = (const float*)(ws + W_MISC); bf16* CKVN = (bf16*)(ws + W_CKVN); bf16* KR = (bf16*)(ws + W_KR);
    float* LOGF = (float*)(ws + W_LOGF); const float* rope = (const float*)(ws + W_ROPE); float* out = a.out;
    const f32x4 gk = *(const f32x4*)(a.in[14] + 4 * lane);
    f32x4 bfv = {0.f, 0.f, 0.f, 0.f}; if (lane == 40 || lane == 41) bfv = *(const f32x4*)(a.in[11] + 4 * (lane - 40));
    for (int m = gw; m < MT; m += NGW) { const float* mr = MISC + (size_t)m * 768;
        f32x4 v1 = {0.f, 0.f, 0.f, 0.f}; if (lane >= 32 && lane < 42) v1 = *(const f32x4*)(mr + 256 + 4 * lane);
        const f32x4 v2 = *(const f32x4*)(mr + 512 + 4 * lane);
        float sk = (v2[0] * v2[0] + v2[1] * v2[1]) + (v2[2] * v2[2] + v2[3] * v2[3]);
        const float rk = __builtin_amdgcn_rsqf(wave_sum(sk) * (1.f / 256.f) + EPS);
        const int er = ext_row(m), orow = out_row(m), pos = pos_of(m);
        { const f32x4 c = v2 * rk * gk; *(u32x2*)(CKVN + (size_t)er * 256 + 4 * lane) = (u32x2){pk2(c[0], c[1]), pk2(c[2], c[3])};
            if (orow >= 0) *(f32x4*)(out + O_CKVP + (size_t)orow * 256 + 4 * lane) = c; else if (orow != (int)0x80000000) *(f32x4*)(out + O_CKVS + (size_t)(-1 - orow) * 256 + 4 * lane) = c; }
        f32x4 pt;
#pragma unroll
        for (int e = 0; e < 4; ++e) pt[e] = __shfl_xor(v1[e], 4);
        if (lane >= 32 && lane < 40) { const int i = lane - 32; const bool first = i < 4; const float* t = rope + ((size_t)pos * 16 + 4 * (i & 3)) * 2;
            const f32x4 t0 = *(const f32x4*)t, t1 = *(const f32x4*)(t + 4); const float sg = first ? -1.f : 1.f; f32x4 c;
            c[0] = v1[0] * t0[0] + sg * pt[0] * t0[1]; c[1] = v1[1] * t0[2] + sg * pt[1] * t0[3]; c[2] = v1[2] * t1[0] + sg * pt[2] * t1[1]; c[3] = v1[3] * t1[2] + sg * pt[3] * t1[3];
            *(u32x2*)(KR + (size_t)er * 32 + 4 * i) = (u32x2){pk2(c[0], c[1]), pk2(c[2], c[3])};
            if (orow >= 0) *(f32x4*)(out + O_KRP + (size_t)orow * 32 + 4 * i) = c; else if (orow != (int)0x80000000) *(f32x4*)(out + O_KRS + (size_t)(-1 - orow) * 32 + 4 * i) = c; }
        if (lane == 40 || lane == 41) { const int i = lane - 40; f32x4 c;
#pragma unroll
            for (int e = 0; e < 4; ++e) { const float z = v1[e] + bfv[e]; c[e] = fminf(z, 0.f) - log1pf(__expf(-fabsf(z))); }
            *(f32x4*)(LOGF + (size_t)er * 8 + 4 * i) = c;
            if (orow >= 0) *(f32x4*)(out + O_LFP + (size_t)orow * 8 + 4 * i) = c; else if (orow != (int)0x80000000) *(f32x4*)(out + O_LFS + (size_t)(-1 - orow) * 8 + 4 * i) = c; }
    }
    for (int t = gw; t < SB * SXR; t += NGW) { const int sb = t / SXR, j = t - sb * SXR; if (j >= PAST && j < PAST + SN) continue;
        const size_t er = (size_t)(MP + t); const bool c = j < PAST; const size_t sr = (size_t)sb * PAST + j;
        { f32x4 v = {0.f, 0.f, 0.f, 0.f}; if (c) v = *(const f32x4*)(a.in[5] + sr * 256 + 4 * lane); *(u32x2*)(CKVN + er * 256 + 4 * lane) = (u32x2){pk2(v[0], v[1]), pk2(v[2], v[3])}; }
        if (lane < 8) { f32x4 v = {0.f, 0.f, 0.f, 0.f}; if (c) v = *(const f32x4*)(a.in[6] + sr * 32 + 4 * lane); *(u32x2*)(KR + er * 32 + 4 * lane) = (u32x2){pk2(v[0], v[1]), pk2(v[2], v[3])}; }
        if (lane < 2) { f32x4 v = {0.f, 0.f, 0.f, 0.f}; if (c) v = *(const f32x4*)(a.in[4] + sr * 8 + 4 * lane); *(f32x4*)(LOGF + er * 8 + 4 * lane) = v; } }
}
__device__ __forceinline__ void p3_scan(const KArgs& a, int gw, int NGW, int lane) {
    const float* LOGF = (const float*)(a.ws + W_LOGF); float* FB = (float*)(a.ws + W_FB);
    for (int s = gw; s < NB * NH + SB * NH; s += NGW) { int base, nch, h;
        if (s < NB * NH) { base = (s >> 3) * LP; nch = LP / 64; h = s & 7; } else { const int t = s - NB * NH; base = MP + (t >> 3) * SXR; nch = SXR / 64; h = t & 7; }
        float carry = 0.f;
        for (int c = 0; c < nch; ++c) { float v = LOGF[(size_t)(base + 64 * c + lane) * 8 + h];
#pragma unroll
            for (int o = 1; o < 64; o <<= 1) { const float t = __shfl_up(v, o); if (lane >= o) v += t; }
            v += carry; FB[(size_t)h * ER + base + 64 * c + lane] = -v * LOG2E; carry = __shfl(v, 63); } }
}
__device__ __forceinline__ void p9_final(const KArgs& a, int gw, int NGW, int lane) {
    const bf16* H = (const bf16*)(a.ws + W_H1B); const float* SS = (const float*)(a.ws + W_SS3); const float* g = a.in[24]; f32x4 gv[4];
#pragma unroll
    for (int j = 0; j < 4; ++j) gv[j] = *(const f32x4*)(g + 4 * lane + 256 * j);
    for (int m = 4 * gw; m < MT; m += 4 * NGW) { float* o;
        if (m >= MP) o = a.out + O_YS + (size_t)(m - MP) * D; else { const int b = m / LP, tp = m - b * LP; if (tp < 64) continue; o = a.out + O_YP + ((size_t)b * SEQ + (tp - 64)) * D; }
        u32x2 w[4][4]; float rs[4];
#pragma unroll
        for (int q = 0; q < 4; ++q) { rs[q] = __builtin_amdgcn_rsqf(SS[m + q] * (1.f / D) + EPS);
#pragma unroll
            for (int j = 0; j < 4; ++j) w[q][j] = *(const u32x2*)(H + (size_t)(m + q) * D + 4 * lane + 256 * j); }
#pragma unroll
        for (int q = 0; q < 4; ++q)
#pragma unroll
            for (int j = 0; j < 4; ++j) *(f32x4*)(o + (size_t)q * D + 4 * lane + 256 * j) = (f32x4){bflo(w[q][j].x), bfhi(w[q][j].x), bflo(w[q][j].y), bfhi(w[q][j].y)} * rs[q] * gv[j]; }
}

struct AttnP { const bf16* Q; const bf16* K1; const bf16* K2; const bf16* V; const float* FB; bf16* O; float* okp; float* ovp; int qpitch, k1pitch, vpitch, opitch, ntiles, q0, nq, cmode, kvlo, qlo, kvhi; float sl2; };
typedef short v4i16_t __attribute__((ext_vector_type(4)));
#define MFMA32(a, b, c) __builtin_amdgcn_mfma_f32_32x32x16_bf16((a), (b), (c), 0, 0, 0)
template <int DK, bool FOX, int BOFF> __device__ __forceinline__ void attn_qk(LAS unsigned char* kl  , const bf16x8 (&qf)[DK / 16], f32x16& p0, f32x16& p1, int lane) {
    constexpr int KP = DK == 64 ? 144 : 208, ND = DK / 16, NF = ND + (FOX ? 1 : 0);
    const int h = lane >> 5;
    bf16x8 ka[NF], kc[NF];
#pragma unroll
    for (int d0 = 0; d0 < ND; ++d0) { ka[d0] = *(const LAS bf16x8*)(kl + BOFF + 32 * d0); kc[d0] = *(const LAS bf16x8*)(kl + BOFF + 32 * KP + 32 * d0); }
    if (FOX) { LAS unsigned char* ka_ = kl - 16 * h + 128; ka[NF - 1] = *(const LAS bf16x8*)(ka_ + BOFF); kc[NF - 1] = *(const LAS bf16x8*)(ka_ + BOFF + 32 * KP); }
    __builtin_amdgcn_sched_barrier(0);
#pragma unroll
    for (int d0 = 0; d0 < ND; ++d0) {
        if (d0 == 0) { f32x16 z;
#pragma unroll
            for (int i = 0; i < 16; ++i) z[i] = 0.f;
            p0 = MFMA32(ka[0], qf[0], z); p1 = MFMA32(kc[0], qf[0], z); } else { p0 = MFMA32(ka[d0], qf[d0], p0); p1 = MFMA32(kc[d0], qf[d0], p1); } }
    if (FOX) { const short one = h == 0 ? (short)0x3F80 : (short)0; const bf16x8 qa = {one, one, one, 0, 0, 0, 0, 0};
        p0 = MFMA32(ka[NF - 1], qa, p0); p1 = MFMA32(kc[NF - 1], qa, p1); }
}
template <int BOFF> __device__ __forceinline__ void attn_sm_pv(LAS unsigned char* vl  , f32x16& p0, f32x16& p1, f32x16& o0, f32x16& o1, float& m_ref, float& l_run,
                                           bool first, int kvbase, bool needmask, int lo_l, int hi_l, int lane) {
    constexpr int VP = 144;
    const int h = lane >> 5;
    s16x4 vlo[8], vhi[8];
    {
#pragma unroll
        for (int k = 0; k < 4; ++k)
#pragma unroll
            for (int db = 0; db < 2; ++db) {
                vlo[2 * k + db] = __builtin_bit_cast(s16x4, __builtin_amdgcn_ds_read_tr16_b64_v4i16((LAS v4i16_t*)(vl + BOFF + (16 * k) * VP + 64 * db)));
                vhi[2 * k + db] = __builtin_bit_cast(s16x4, __builtin_amdgcn_ds_read_tr16_b64_v4i16((LAS v4i16_t*)(vl + BOFF + (16 * k + 8) * VP + 64 * db))); } }
    __builtin_amdgcn_sched_barrier(0);
    if (needmask) {
#pragma unroll
        for (int i = 0; i < 16; ++i) { const int kv = kvbase + (i & 3) + 8 * (i >> 2) + 4 * h;
            if (kv < lo_l || kv > hi_l) p0[i] = -INFINITY;
            if (kv + 32 < lo_l || kv + 32 > hi_l) p1[i] = -INFINITY; } }
    float ma = fmaxf(fmaxf(p0[0], p0[1]), p1[0]), mb = fmaxf(fmaxf(p0[2], p0[3]), p1[1]);
    ma = fmaxf(fmaxf(ma, p1[2]), p1[3]);
#pragma unroll
    for (int i = 4; i < 16; i += 4) { ma = fmaxf(fmaxf(ma, p0[i]), p0[i + 1]); mb = fmaxf(fmaxf(mb, p0[i + 2]), p0[i + 3]); ma = fmaxf(fmaxf(ma, p1[i]), p1[i + 1]); mb = fmaxf(fmaxf(mb, p1[i + 2]), p1[i + 3]); }
    float mx = fmaxf(ma, mb);
    { const auto rr = __builtin_amdgcn_permlane32_swap(__float_as_uint(mx), __float_as_uint(mx), false, false); mx = fmaxf(__uint_as_float(rr[0]), __uint_as_float(rr[1])); }
    const bool need = first || (mx - m_ref) > 8.f;
    if (__any(need)) { float dl = first ? mx : fmaxf(mx - m_ref, 0.f); if (!need || dl == -INFINITY) dl = 0.f;
        m_ref += dl; const float alpha = __builtin_amdgcn_exp2f(-dl); l_run *= alpha;
#pragma unroll
        for (int i = 0; i < 16; ++i) { o0[i] *= alpha; o1[i] *= alpha; } }
    float ps = 0.f, pt = 0.f;
#pragma unroll
    for (int i = 0; i < 16; ++i) { p0[i] = __builtin_amdgcn_exp2f(p0[i] - m_ref); p1[i] = __builtin_amdgcn_exp2f(p1[i] - m_ref); ps += p0[i]; pt += p1[i]; }
    l_run += ps + pt;
    bf16x8 pf[4];
#pragma unroll
    for (int s2 = 0; s2 < 2; ++s2) {
        u32x4 w0 = {pk2(p0[8 * s2], p0[8 * s2 + 1]), pk2(p0[8 * s2 + 2], p0[8 * s2 + 3]), pk2(p0[8 * s2 + 4], p0[8 * s2 + 5]), pk2(p0[8 * s2 + 6], p0[8 * s2 + 7])};
        u32x4 w1 = {pk2(p1[8 * s2], p1[8 * s2 + 1]), pk2(p1[8 * s2 + 2], p1[8 * s2 + 3]), pk2(p1[8 * s2 + 4], p1[8 * s2 + 5]), pk2(p1[8 * s2 + 6], p1[8 * s2 + 7])};
        pf[s2] = __builtin_bit_cast(bf16x8, w0); pf[2 + s2] = __builtin_bit_cast(bf16x8, w1); }
#pragma unroll
    for (int k = 0; k < 4; ++k) {
        const bf16x8 v0 = __builtin_shufflevector(vlo[2 * k], vhi[2 * k], 0, 1, 2, 3, 4, 5, 6, 7), v1 = __builtin_shufflevector(vlo[2 * k + 1], vhi[2 * k + 1], 0, 1, 2, 3, 4, 5, 6, 7);
        o0 = MFMA32(v0, pf[k], o0); o1 = MFMA32(v1, pf[k], o1); }
}
#ifndef SGV
#define SGV 8
#endif
template <int DK, bool FOX, int KOFF, int VOFF> __device__ __forceinline__ void attn_fused(LAS unsigned char* kl, LAS unsigned char* vl, const bf16x8 (&qf)[DK / 16], f32x16& p0, f32x16& p1, f32x16& pn0, f32x16& pn1,
                                                                                        f32x16& o0, f32x16& o1, float& m_ref, float& l_run, bool first, int kvbase, bool needmask, int lo_l, int hi_l, int lane) {
    constexpr int KP = DK == 64 ? 144 : 208, VP = 144, ND = DK / 16, NF = ND + (FOX ? 1 : 0);
    const int h = lane >> 5;
    bf16x8 ka[NF], kc[NF];
#pragma unroll
    for (int d0 = 0; d0 < ND; ++d0) { ka[d0] = *(const LAS bf16x8*)(kl + KOFF + 32 * d0); kc[d0] = *(const LAS bf16x8*)(kl + KOFF + 32 * KP + 32 * d0); }
    if (FOX) { LAS unsigned char* ka_ = kl - 16 * h + 128; ka[NF - 1] = *(const LAS bf16x8*)(ka_ + KOFF); kc[NF - 1] = *(const LAS bf16x8*)(ka_ + KOFF + 32 * KP); }
    if (needmask) {
#pragma unroll
        for (int i = 0; i < 16; ++i) { const int kv = kvbase + (i & 3) + 8 * (i >> 2) + 4 * h;
            if (kv < lo_l || kv > hi_l) p0[i] = -INFINITY;
            if (kv + 32 < lo_l || kv + 32 > hi_l) p1[i] = -INFINITY; } }
    float ma = fmaxf(fmaxf(p0[0], p0[1]), p1[0]), mb = fmaxf(fmaxf(p0[2], p0[3]), p1[1]);
    ma = fmaxf(fmaxf(ma, p1[2]), p1[3]);
#pragma unroll
    for (int i = 4; i < 16; i += 4) { ma = fmaxf(fmaxf(ma, p0[i]), p0[i + 1]); mb = fmaxf(fmaxf(mb, p0[i + 2]), p0[i + 3]); ma = fmaxf(fmaxf(ma, p1[i]), p1[i + 1]); mb = fmaxf(fmaxf(mb, p1[i + 2]), p1[i + 3]); }
    float mx = fmaxf(ma, mb);
    { const auto rr = __builtin_amdgcn_permlane32_swap(__float_as_uint(mx), __float_as_uint(mx), false, false); mx = fmaxf(__uint_as_float(rr[0]), __uint_as_float(rr[1])); }
    const bool need = first || (mx - m_ref) > 8.f;
    float dl = first ? mx : fmaxf(mx - m_ref, 0.f); if (!need || dl == -INFINITY) dl = 0.f;
    m_ref += dl; const float alpha = __builtin_amdgcn_exp2f(-dl); l_run *= alpha;
    __builtin_amdgcn_sched_barrier(0);
    float ps = 0.f, pt = 0.f;
#pragma unroll
    for (int g = 0; g < NF; ++g) {
        if (g < ND) { if (g == 0) { f32x16 z;
#pragma unroll
                for (int i = 0; i < 16; ++i) z[i] = 0.f;
                pn0 = MFMA32(ka[0], qf[0], z); } else pn0 = MFMA32(ka[g < ND ? g : 0], qf[g < ND ? g : 0], pn0); }
        else { const short one = h == 0 ? (short)0x3F80 : (short)0; const bf16x8 qa = {one, one, one, 0, 0, 0, 0, 0}; pn0 = MFMA32(ka[NF - 1], qa, pn0); }
#pragma unroll
        for (int i = (16 * g) / NF; i < (16 * (g + 1)) / NF; ++i) { o0[i] *= alpha;
#ifdef PROBE_EXP
            { float d_ = __builtin_amdgcn_exp2f(p0[i] - m_ref + 1.f); asm volatile("" :: "v"(d_)); }
#endif
            p0[i] = __builtin_amdgcn_exp2f(p0[i] - m_ref); ps += p0[i]; }
        __builtin_amdgcn_sched_barrier(0);
        if (g < ND) { if (g == 0) { f32x16 z;
#pragma unroll
                for (int i = 0; i < 16; ++i) z[i] = 0.f;
                pn1 = MFMA32(kc[0], qf[0], z); } else pn1 = MFMA32(kc[g < ND ? g : 0], qf[g < ND ? g : 0], pn1); }
        else { const short one = h == 0 ? (short)0x3F80 : (short)0; const bf16x8 qa = {one, one, one, 0, 0, 0, 0, 0}; pn1 = MFMA32(kc[NF - 1], qa, pn1); }
#pragma unroll
        for (int i = (16 * g) / NF; i < (16 * (g + 1)) / NF; ++i) { o1[i] *= alpha;
#ifdef PROBE_EXP
            { float d_ = __builtin_amdgcn_exp2f(p1[i] - m_ref + 1.f); asm volatile("" :: "v"(d_)); }
#endif
            p1[i] = __builtin_amdgcn_exp2f(p1[i] - m_ref); pt += p1[i]; }
        __builtin_amdgcn_sched_barrier(0);
    }
    l_run += ps + pt;
    __builtin_amdgcn_sched_barrier(0);
    s16x4 vlo[8], vhi[8];
#pragma unroll
    for (int k = 0; k < 4; ++k)
#pragma unroll
        for (int db = 0; db < 2; ++db) {
            vlo[2 * k + db] = __builtin_bit_cast(s16x4, __builtin_amdgcn_ds_read_tr16_b64_v4i16((LAS v4i16_t*)(vl + VOFF + (16 * k) * VP + 64 * db)));
            vhi[2 * k + db] = __builtin_bit_cast(s16x4, __builtin_amdgcn_ds_read_tr16_b64_v4i16((LAS v4i16_t*)(vl + VOFF + (16 * k + 8) * VP + 64 * db))); }
    bf16x8 pf[4];
#pragma unroll
    for (int s2 = 0; s2 < 2; ++s2) {
        u32x4 w0 = {pk2(p0[8 * s2], p0[8 * s2 + 1]), pk2(p0[8 * s2 + 2], p0[8 * s2 + 3]), pk2(p0[8 * s2 + 4], p0[8 * s2 + 5]), pk2(p0[8 * s2 + 6], p0[8 * s2 + 7])};
        u32x4 w1 = {pk2(p1[8 * s2], p1[8 * s2 + 1]), pk2(p1[8 * s2 + 2], p1[8 * s2 + 3]), pk2(p1[8 * s2 + 4], p1[8 * s2 + 5]), pk2(p1[8 * s2 + 6], p1[8 * s2 + 7])};
        pf[s2] = __builtin_bit_cast(bf16x8, w0); pf[2 + s2] = __builtin_bit_cast(bf16x8, w1); }
#pragma unroll
    for (int k = 0; k < 4; ++k) {
        const bf16x8 v0 = __builtin_shufflevector(vlo[2 * k], vhi[2 * k], 0, 1, 2, 3, 4, 5, 6, 7), v1 = __builtin_shufflevector(vlo[2 * k + 1], vhi[2 * k + 1], 0, 1, 2, 3, 4, 5, 6, 7);
        o0 = MFMA32(v0, pf[k], o0); o1 = MFMA32(v1, pf[k], o1); }
}
template <int DK, bool FOX> __device__ __forceinline__ void attn_unit(LAS unsigned char* lds, const AttnP& P) {
    constexpr int KP = DK == 64 ? 144 : 208, VP = 144, KBYTES = 64 * KP, VBYTES = 64 * VP, ND = DK / 16;
    int tid_ = threadIdx.x; asm volatile("" : "+v"(tid_));
    const int tid = tid_, lane = tid & 63, wid = __builtin_amdgcn_readfirstlane(tid >> 6), r = lane & 31, h = lane >> 5;
    const int lrow = tid >> 3, lch = tid & 7;
    LAS unsigned char* KB = lds; LAS unsigned char* VB = lds + 2 * KBYTES;
    LAS unsigned char* kl = KB + r * KP + 16 * h; LAS unsigned char* vl = VB + (4 * h + ((lane & 15) >> 2)) * VP + 32 * ((lane >> 4) & 1) + 8 * (lane & 3);
    const int q_abs = P.q0 + 32 * wid + r;
    const int qlim = P.cmode == 1 ? q_abs : (P.cmode == 2 ? (q_abs | 63) : 0x7fffffff);
    const int hi_l = qlim < P.kvhi - 1 ? qlim : P.kvhi - 1, lo_l = q_abs >= P.qlo ? P.kvlo : 0;
    const int qa0 = P.q0 + 32 * wid, qa1 = qa0 + 31;
    const int ql0 = P.cmode == 1 ? qa0 : (P.cmode == 2 ? (qa0 | 63) : 0x7fffffff), ql1 = P.cmode == 1 ? qa1 : (P.cmode == 2 ? (qa1 | 63) : 0x7fffffff);
    const int mnh = ql0 < P.kvhi - 1 ? ql0 : P.kvhi - 1, mxh = ql1 < P.kvhi - 1 ? ql1 : P.kvhi - 1, mxl = qa1 >= P.qlo ? P.kvlo : 0;
    const bool active = 32 * wid < P.nq;
    const int last_tile = (mxh >> 6) < P.ntiles - 1 ? (mxh >> 6) : P.ntiles - 1;
    bf16x8 qf[ND];
#pragma unroll
    for (int d0 = 0; d0 < ND; ++d0) { if (active) qf[d0] = *(const bf16x8*)(P.Q + (size_t)(32 * wid + r) * P.qpitch + 16 * d0 + 8 * h); else qf[d0] = (bf16x8){0, 0, 0, 0, 0, 0, 0, 0}; }
    float m_ref = 0.f, l_run = 0.f; f32x16 o0, o1, p0, p1, pn0, pn1;
#pragma unroll
    for (int i = 0; i < 16; ++i) { o0[i] = 0.f; o1[i] = 0.f; p0[i] = 0.f; p1[i] = 0.f; pn0[i] = 0.f; pn1[i] = 0.f; }
    u32x4 ak1 = {0u, 0u, 0u, 0u}, ak2 = {0u, 0u, 0u, 0u}, av = {0u, 0u, 0u, 0u}; float afb = 0.f;
#define A_LOADK(S, jt) do { S##k1 = *(const u32x4*)(P.K1 + (size_t)((jt) * 64 + lrow) * P.k1pitch + lch * 8); \
        if (DK == 96) S##k2 = *(const u32x4*)(P.K2 + (size_t)((jt) * 64 + ((tid >> 2) & 63)) * 32 + (tid & 3) * 8); \
        if (FOX) S##fb = P.FB[(jt) * 64 + (tid & 63)]; } while (0)
#define A_LOADV(S, jt) do { S##v = *(const u32x4*)(P.V + (size_t)((jt) * 64 + lrow) * P.vpitch + lch * 8); } while (0)
#define A_OUT8(ptr, VV, jt) do { if (FOX && (ptr) != nullptr) { const int tp_ = (jt) * 64 + lrow; if (tp_ >= PADR) { float* o_ = (ptr) + (size_t)tp_ * 512 + lch * 8; const u32x4 q_ = (VV); \
            *(f32x4*)o_ = (f32x4){bflo(q_.x), bfhi(q_.x), bflo(q_.y), bfhi(q_.y)}; *(f32x4*)(o_ + 4) = (f32x4){bflo(q_.z), bfhi(q_.z), bflo(q_.w), bfhi(q_.w)}; } } } while (0)
#define A_STOREK(S, b) do { LAS unsigned char* kb_ = KB + (b) * KBYTES; *(LAS u32x4*)(kb_ + lrow * KP + lch * 16) = S##k1; \
        if (DK == 96 && tid < 256) *(LAS u32x4*)(kb_ + (tid >> 2) * KP + 128 + (tid & 3) * 16) = S##k2; \
        if (FOX && tid < 64) { const unsigned w0_ = pk2(S##fb, 0.f) & 0xffffu; const float e1_ = S##fb - __uint_as_float(w0_ << 16); const unsigned w1_ = pk2(e1_, 0.f) & 0xffffu; const float e2_ = e1_ - __uint_as_float(w1_ << 16); \
            *(LAS u32x4*)(kb_ + tid * KP + 128) = (u32x4){w0_ | (w1_ << 16), pk2(e2_, 0.f) & 0xffffu, 0u, 0u}; } } while (0)
#define A_STOREV(S, b) do { *(LAS u32x4*)(VB + (b) * VBYTES + lrow * VP + lch * 16) = S##v; } while (0)
#define A_ITER(jt, L, S, PAR) do { const int jt_ = (jt); \
        { const int lk_ = jt_ + 2 < P.ntiles ? jt_ + 2 : P.ntiles - 1, lv_ = jt_ + 1 < P.ntiles ? jt_ + 1 : P.ntiles - 1; A_LOADK(a, lk_); A_LOADV(a, lv_); } \
        const bool mv_ = jt_ + 1 < P.ntiles; \
        const bool do_next = active && mv_ && jt_ + 1 <= last_tile, do_cur = active && jt_ <= last_tile; \
        const int kvbase = jt_ * 64; const bool needmask = (kvbase < mxl) || (kvbase + 63 > mnh); \
        if (active && jt_ <= last_tile) attn_fused<DK, FOX, (1 - PAR) * KBYTES, PAR * VBYTES>(kl, vl, qf, p0, p1, pn0, pn1, o0, o1, m_ref, l_run, jt_ == 0, kvbase, needmask, lo_l, hi_l, lane); \
        if (jt_ + 2 < P.ntiles) { A_STOREK(a, PAR); A_OUT8(P.okp, ak1, jt_ + 2); } \
        if (mv_) { A_STOREV(a, 1 - PAR); A_OUT8(P.ovp, av, jt_ + 1); } \
        asm volatile("s_waitcnt lgkmcnt(0)" ::: "memory"); __builtin_amdgcn_s_barrier(); asm volatile("" ::: "memory");     \
        p0 = pn0; p1 = pn1; } while (0)
    A_LOADK(a, 0); A_LOADV(a, 0); A_STOREK(a, 0); A_STOREV(a, 0); A_OUT8(P.okp, ak1, 0); A_OUT8(P.ovp, av, 0);
    if (P.ntiles > 1) { A_LOADK(a, 1); A_STOREK(a, 1); A_OUT8(P.okp, ak1, 1); }
    __syncthreads();
    if (active) attn_qk<DK, FOX, 0>(kl, qf, p0, p1, lane);
    __syncthreads();
    for (int jt = 0; jt < P.ntiles; jt += 2) {
        A_ITER(jt, a, b, 0);
        if (jt + 1 < P.ntiles) A_ITER(jt + 1, b, a, 1);
    }
#undef A_ITER
#undef A_LOADK
#undef A_LOADV
#undef A_STOREK
#undef A_STOREV
#undef A_OUT8
    float l; { const auto rr = __builtin_amdgcn_permlane32_swap(__float_as_uint(l_run), __float_as_uint(l_run), false, false); l = __uint_as_float(rr[0]) + __uint_as_float(rr[1]); }
    const float rl = 1.f / l;
    if (active && 32 * wid + r < P.nq) { bf16* op = P.O + (size_t)(32 * wid + r) * P.opitch + 4 * h;
#pragma unroll
        for (int g = 0; g < 4; ++g) {
            *(u32x2*)(op + 8 * g) = (u32x2){pk2(o0[4 * g] * rl, o0[4 * g + 1] * rl), pk2(o0[4 * g + 2] * rl, o0[4 * g + 3] * rl)};
            *(u32x2*)(op + 32 + 8 * g) = (u32x2){pk2(o1[4 * g] * rl, o1[4 * g + 1] * rl), pk2(o1[4 * g + 2] * rl, o1[4 * g + 3] * rl)}; } }
}
__device__ __forceinline__ void p4_attention(const KArgs& a, LAS unsigned char* lds, int vcu, int G) {
    unsigned char* ws = a.ws; const bf16* FQ = (const bf16*)(ws + W_FQ); bf16* OF = (bf16*)(ws + W_OCAT); const bf16* FK = (const bf16*)(ws + W_FK); const bf16* FV = (const bf16*)(ws + W_FV); const float* FB = (const float*)(ws + W_FB);
    const bf16* QM = (const bf16*)(ws + W_QMLA); const bf16* KV = (const bf16*)a.out; const bf16* KR = (const bf16*)(ws + W_KR); bf16* OM = (bf16*)(ws + W_OCAT) + 512;
    const float slf = 0.125f * LOG2E, slm = 0.10206207261596575f * LOG2E;
    for (int c = vcu; c < 256; c += G) { const int b = c >> 3, h = c & 7; const size_t r0 = (size_t)b * LP;
        for (int blk = 8; blk >= 0; --blk) { const int q0 = blk == 0 ? 0 : 64 + 256 * (blk - 1), nq = blk == 0 ? 64 : 256, nt = 4 * blk + 1;
            { AttnP P; P.Q = FQ + (r0 + q0) * 512 + h * 64; P.K1 = FK + r0 * 512 + h * 64; P.K2 = nullptr; P.V = FV + r0 * 512 + h * 64; P.FB = FB + (size_t)h * ER + r0; P.O = OF + (r0 + q0) * 1024 + h * 64; P.okp = blk == 8 ? a.out + O_KP + ((long)b * LSEQ - PADR) * 512 + h * 64 : nullptr; P.ovp = blk == 8 ? a.out + O_VP + ((long)b * LSEQ - PADR) * 512 + h * 64 : nullptr;
                P.qpitch = 512; P.k1pitch = 512; P.vpitch = 512; P.opitch = 1024; P.ntiles = nt; P.q0 = q0; P.nq = nq; P.cmode = 1; P.kvlo = PADR; P.qlo = PADR; P.kvhi = LP; P.sl2 = slf;
                attn_unit<64, true>(lds, P); }
            { AttnP P; P.Q = QM + (r0 + q0) * 768 + h * 96; P.K1 = KV + r0 * 1024 + h * 128; P.K2 = KR + r0 * 32; P.V = KV + r0 * 1024 + h * 128 + 64; P.FB = nullptr; P.okp = nullptr; P.ovp = nullptr; P.O = OM + (r0 + q0) * 1024 + h * 64;
                P.qpitch = 768; P.k1pitch = 1024; P.vpitch = 1024; P.opitch = 1024; P.ntiles = nt; P.q0 = q0; P.nq = nq; P.cmode = 2; P.kvlo = PADR; P.qlo = PADR; P.kvhi = LP; P.sl2 = slm;
                attn_unit<96, false>(lds, P); } }
        { const int typ = c >> 7, sb = (c & 127) >> 3; const size_t e0 = (size_t)MP + (size_t)sb * SXR, t0 = (size_t)MP + (size_t)sb * SN;
            if (typ == 0) { AttnP P; P.Q = FQ + t0 * 512 + h * 64; P.K1 = FK + e0 * 512 + h * 64; P.K2 = nullptr; P.V = FV + e0 * 512 + h * 64; P.FB = FB + (size_t)h * ER + e0; P.okp = nullptr; P.ovp = nullptr; P.O = OF + t0 * 1024 + h * 64;
                P.qpitch = 512; P.k1pitch = 512; P.vpitch = 512; P.opitch = 1024; P.ntiles = 17; P.q0 = PAST; P.nq = SN; P.cmode = 1; P.kvlo = 0; P.qlo = 0; P.kvhi = PAST + SN; P.sl2 = slf;
                attn_unit<64, true>(lds, P); }
            else { AttnP P; P.Q = QM + t0 * 768 + h * 96; P.K1 = KV + e0 * 1024 + h * 128; P.K2 = KR + e0 * 32; P.V = KV + e0 * 1024 + h * 128 + 64; P.FB = nullptr; P.okp = nullptr; P.ovp = nullptr; P.O = OM + t0 * 1024 + h * 64;
                P.qpitch = 768; P.k1pitch = 1024; P.vpitch = 1024; P.opitch = 1024; P.ntiles = 17; P.q0 = PAST; P.nq = SN; P.cmode = 0; P.kvlo = 0; P.qlo = 0; P.kvhi = PAST + SN; P.sl2 = slm;
                attn_unit<96, false>(lds, P); } }
    }
}

__device__ __forceinline__ void stagger(int bx, int step_ticks) {
    const unsigned long long t0 = __builtin_amdgcn_s_memrealtime(); const unsigned long long w = (unsigned long long)(((bx >> 3) & 7) * step_ticks);
    while (__builtin_amdgcn_s_memrealtime() - t0 < w) __builtin_amdgcn_s_sleep(16);
}
#ifndef STAG
#define STAG 0
#endif
#ifndef REP_P1
#define REP_P1 1
#endif
#ifndef REP_P4
#define REP_P4 1
#endif
#ifndef REP_P7
#define REP_P7 1
#endif
#define XB_TMO      128
#define XB_XCNT(j)  (256  + 64 * (j))
#define XB_XSUB(j)  (1280 + 64 * (j))
#define XB_XGEN(j)  (2304 + 64 * (j))
#define XB_TOP      3328
#define XB_TOPGEN   3392
#define XCD_BAR_WORDS 3456
#define XB_SPIN_CAP (1u << 18)

__device__ __forceinline__ unsigned xb_ld(unsigned* p)              { return __hip_atomic_load(p, __ATOMIC_RELAXED, __HIP_MEMORY_SCOPE_AGENT); }
__device__ __forceinline__ unsigned xb_add(unsigned* p, unsigned v) { return __hip_atomic_fetch_add(p, v, __ATOMIC_RELAXED, __HIP_MEMORY_SCOPE_AGENT); }
__device__ __forceinline__ unsigned xb_xcc_id() { return (unsigned)__builtin_amdgcn_s_getreg((3 << 11) | 20) & 0xFu; }
#define XB_SPIN(cond, bar) do { unsigned _sp = 0; while (cond) { __builtin_amdgcn_s_sleep(1); \
    if ((++_sp & 255u) == 0u) { if (xb_ld(&(bar)[XB_TMO])) break; if (_sp > XB_SPIN_CAP) { atomicAdd(&(bar)[XB_TMO], 1u); break; } } } } while (0)

struct XcdBarrier {
    unsigned* bar; unsigned x;
    volatile LAS unsigned* st;
};

__device__ __forceinline__ XcdBarrier xcd_barrier_post(unsigned* bar, volatile LAS unsigned* st) {
    XcdBarrier b; b.bar = bar; b.x = xb_xcc_id(); b.st = st;
    if (threadIdx.x == 0) (void)xb_add(&bar[XB_XCNT(b.x)], 1u);
    return b;
}
__device__ __forceinline__ void xcd_barrier_complete(unsigned* bar, unsigned x, unsigned& nloc, unsigned& nx) {
    const unsigned G = gridDim.x * gridDim.y * gridDim.z;
    unsigned sum, cnt, mine, sp = 0u;
    for (;;) {
        sum = 0u; cnt = 0u; mine = 0u;
#pragma unroll
        for (unsigned j = 0; j < 16; ++j) { const unsigned c = xb_ld(&bar[XB_XCNT(j)]); sum += c; cnt += (c > 0u) ? 1u : 0u; mine = (j == x) ? c : mine; }
        if (sum == G) break;
        __builtin_amdgcn_s_sleep(1);
        if ((++sp & 255u) == 0u) { if (xb_ld(&bar[XB_TMO])) break; if (sp > XB_SPIN_CAP) { atomicAdd(&bar[XB_TMO], 1u); break; } }
    }
    nloc = mine > 0u ? mine : 1u; nx = cnt > 0u ? cnt : 1u;
}

__device__ __forceinline__ void xcd_barrier(const XcdBarrier& b) {
    asm volatile("s_waitcnt vmcnt(0)" ::: "memory");
    __syncthreads();
    if (threadIdx.x == 0) {
        unsigned* bar = b.bar;
        __builtin_amdgcn_s_waitcnt(0);
        unsigned nloc = b.st[0], nx = b.st[1];
        if (nloc == 0u) { xcd_barrier_complete(bar, b.x, nloc, nx); b.st[0] = nloc; b.st[1] = nx; }
        const unsigned old = xb_add(&bar[XB_XSUB(b.x)], 1u);
        const unsigned gen = old / nloc;
        if (old + 1u == (gen + 1u) * nloc) {
            __builtin_amdgcn_fence(__ATOMIC_RELEASE, "agent");
            asm volatile("s_waitcnt vmcnt(0)" ::: "memory");
            const unsigned og = xb_add(&bar[XB_TOP], 1u);
            const unsigned tg = og / nx;
            if (og + 1u == (tg + 1u) * nx) xb_add(&bar[XB_TOPGEN], 1u);
            else XB_SPIN(xb_ld(&bar[XB_TOPGEN]) == tg, bar);
            __builtin_amdgcn_fence(__ATOMIC_ACQUIRE, "agent");
            xb_add(&bar[XB_XGEN(b.x)], 1u);
            asm volatile("s_waitcnt vmcnt(0)" ::: "memory");
        } else {
            XB_SPIN(xb_ld(&bar[XB_XGEN(b.x)]) == gen, bar);
            __builtin_amdgcn_fence(__ATOMIC_ACQUIRE, "agent");
            asm volatile("s_waitcnt vmcnt(0)" ::: "memory");
        }
    }
    __syncthreads();
}

constexpr int LDS_BYTES = 147456;
typedef const __attribute__((address_space(4))) KArgs* kargs_cptr;
#if defined(__HIP_DEVICE_COMPILE__)
__device__ __forceinline__ KArgs load_args() { auto p = __builtin_amdgcn_kernarg_segment_ptr(); asm volatile("" : "+s"(p)); const kargs_cptr q = (kargs_cptr)p; KArgs r;
#pragma unroll
    for (int i = 0; i < 25; ++i) r.in[i] = q->in[i];
    r.out = q->out; r.ws = q->ws; return r; }
#else
__device__ __forceinline__ KArgs load_args() { return KArgs{}; }
#endif
#define LANEVARS int t_ = threadIdx.x; asm volatile("" : "+v"(t_)); const int lane = t_ & 63, wave = __builtin_amdgcn_readfirstlane(t_ >> 6), gw = vcu * 8 + wave, gtid = bx * 512 + t_; (void)gtid; (void)lane; (void)gw
#define PHASE_BEGIN const KArgs a = load_args(); unsigned char* ws = a.ws; (void)ws; const int G = gridDim.x, bx = blockIdx.x, vcu = (G % 8 == 0) ? (bx % 8) * (G / 8) + bx / 8 : bx, NGW = G * 8, NT = G * 512; (void)NGW; (void)NT; (void)vcu; const pg8::AMap nat{0, 0, 256}; (void)nat
#define SEAM() do { __syncthreads(); grid.sync(); } while (0)
#define SEAMX() xcd_barrier(xbar)
__global__ void __launch_bounds__(512, 2) mega_fwd(KArgs a_in) {
    extern __shared__ __attribute__((aligned(16))) unsigned char lds_raw[];
    cg::grid_group grid = cg::this_grid();
    LAS unsigned char* lds = (LAS unsigned char*)lds_raw;
    (void)a_in;
    volatile LAS unsigned* xst = (volatile LAS unsigned*)(lds + 131072 + 1024);
    if (threadIdx.x < 2) xst[threadIdx.x] = 0u;
    __syncthreads();
    const XcdBarrier xbar = xcd_barrier_post((unsigned*)(load_args().ws + W_BAR), xst);
    { PHASE_BEGIN; LANEVARS; p0_prologue(a, lds, gw, NGW, wave, lane, gtid, NT); }
    SEAM();
    for (int rep_ = 0; rep_ < REP_P1; ++rep_) { PHASE_BEGIN;
        pg8::Gemm g{(const bf16*)(ws + W_XN), (const bf16*)(ws + W_WIN), MT, INWP, D}; pg8::StaticOrder S; S.init(MT, INWP, G, bx);
        pg8::EpiWin E{(bf16*)(ws + W_FQ), (bf16*)(ws + W_FK), (bf16*)(ws + W_FV), (bf16*)(ws + W_GATES), (float*)(ws + W_MISC), a.out, (bf16*)(ws + W_CQ), (float*)(ws + W_SSQ)};
        pg8::gemm_phase<pg8::EpiWin, pg8::StaticOrder, true, true>(lds, g, S, E, nat); }
    SEAMX();
    { PHASE_BEGIN; LANEVARS; p2_fixup(a, gw, NGW, lane); }
    SEAMX();
    { PHASE_BEGIN; LANEVARS; p3_scan(a, gw, NGW, lane); }
    { PHASE_BEGIN; pg8::Gemm g{(const bf16*)(ws + W_CQ), (const bf16*)(ws + W_WUQ), MT, 768, 384}; pg8::StaticOrder S; S.init(MT, 768, G, bx);
        pg8::EpiQ E{(bf16*)(ws + W_QMLA), (const float*)(ws + W_ROPE), (const float*)(ws + W_SSQ)};
        pg8::gemm_phase<pg8::EpiQ, pg8::StaticOrder, true, true>(lds, g, S, E, nat); }
    { PHASE_BEGIN; pg8::Gemm g{(const bf16*)(ws + W_CKVN), (const bf16*)(ws + W_WUKV), ER, 1024, 256}; pg8::StaticOrder S; S.init(ER, 1024, G, bx);
        pg8::EpiPlain E{(bf16*)a.out, 1024};
        pg8::gemm_phase<pg8::EpiPlain, pg8::StaticOrder, true, true>(lds, g, S, E, nat); }
    SEAMX();
    { PHASE_BEGIN; p4_attention(a, lds, vcu, G); }
#if REP_P4 > 1
    SEAMX();
    { PHASE_BEGIN; p4_attention(a, lds, vcu, G); }
#endif
    SEAMX();
    { PHASE_BEGIN; pg8::Gemm g{(const bf16*)(ws + W_OCAT), (const bf16*)(ws + W_WOC), MT, D, 1024}; pg8::StaticOrder S; S.init(MT, D, G, bx);
        pg8::EpiMixCat E{(bf16*)(ws + W_MIX), (const bf16*)(ws + W_GATES)};
        pg8::gemm_phase<pg8::EpiMixCat, pg8::StaticOrder, true, true>(lds, g, S, E, nat); }
    SEAMX();
    { PHASE_BEGIN; pg8::Gemm g{(const bf16*)(ws + W_MIX), (const bf16*)(ws + W_WOUT), MT, D, D}; pg8::StaticOrder S; S.init(MT, D, G, bx);
        pg8::EpiH1 E{a.in[0], a.in[8], a.in[1], (float*)(ws + W_H1), (bf16*)(ws + W_H1B), (float*)(ws + W_SS2)};
        pg8::gemm_phase<pg8::EpiH1, pg8::StaticOrder, true, true>(lds, g, S, E, nat); }
    SEAMX();
    for (int rep_ = 0; rep_ < REP_P7; ++rep_) {
    { PHASE_BEGIN; pg8::Gemm g{(const bf16*)(ws + W_H1B), (const bf16*)(ws + W_WUP), 269 * 256, UPW, D}; pg8::StaticOrder S; S.init(269 * 256, UPW, G, bx);
        pg8::EpiConv<false> E{(bf16*)(ws + W_G), (const float*)(ws + W_SS2), a.in[21], a.in[22], a.in[7], a.out, 126};
        pg8::gemm_phase<pg8::EpiConv<false>, pg8::StaticOrder, true, true>(lds, g, S, E, pg8::AMap{1, 126, 252}); }
    { PHASE_BEGIN; pg8::Gemm g{(const bf16*)(ws + W_H1B) + (size_t)MP * D, (const bf16*)(ws + W_WUP), 256, UPW, D}; pg8::StaticOrder S; S.init(256, UPW, G, G - 1 - bx);
        pg8::EpiConv<true> E{(bf16*)(ws + W_G), (const float*)(ws + W_SS2), a.in[21], a.in[22], a.in[7], a.out, 128};
        pg8::gemm_phase<pg8::EpiConv<true>, pg8::StaticOrder, true, true>(lds, g, S, E, pg8::AMap{1, 128, 256}); }
    }
    SEAMX();
    { PHASE_BEGIN; pg8::Gemm g{(const bf16*)(ws + W_G), (const bf16*)(ws + W_WDN), MT, D, DFF}; pg8::StaticOrder S; S.init(MT, D, G, bx);
        pg8::EpiH2 E{(bf16*)(ws + W_H1B), (float*)(ws + W_SS3)};
        pg8::gemm_phase<pg8::EpiH2, pg8::StaticOrder, true, true>(lds, g, S, E, nat); }
    SEAMX();
    { PHASE_BEGIN; LANEVARS; p9_final(a, gw, NGW, lane); }
}

extern "C" void kernel_launch(void* const* d_in, const int* in_sizes, int n_in, void* d_out, int out_size, void* d_ws, size_t ws_size, hipStream_t stream) {
    static int grid = 0;
    if (grid == 0) {
        if (n_in != 25 || (size_t)out_size != O_END || ws_size < W_END) { fprintf(stderr, "kernel_launch: unexpected sizes n_in %d out %d (want %zu) ws %zu (want %zu)\n", n_in, out_size, (size_t)O_END, ws_size, (size_t)W_END); grid = -1; return; }
        int dev = 0, cus = 0, per_cu = 0;
        hipGetDevice(&dev); hipDeviceGetAttribute(&cus, hipDeviceAttributeMultiprocessorCount, dev);
        hipFuncSetAttribute((const void*)mega_fwd, hipFuncAttributeMaxDynamicSharedMemorySize, LDS_BYTES);
        hipOccupancyMaxActiveBlocksPerMultiprocessor(&per_cu, (const void*)mega_fwd, 512, LDS_BYTES);
        (void)hipGetLastError();
        if (per_cu < 1) per_cu = 1;
        grid = cus;
        if (grid > 256) grid = 256;
    }
    if (grid < 0) return;
    if (hipMemsetAsync((char*)d_ws + W_BAR, 0, XCD_BAR_WORDS * 4, stream) != hipSuccess) { fprintf(stderr, "kernel_launch: hipMemsetAsync failed\n"); return; }
    KArgs a{};
    for (int i = 0; i < 25; ++i) a.in[i] = (const float*)d_in[i];
    a.out = (float*)d_out; a.ws = (unsigned char*)d_ws;
    void* args[] = {&a};
    hipError_t e = hipLaunchCooperativeKernel((const void*)mega_fwd, dim3(grid), dim3(512), args, LDS_BYTES, stream);
    if (e != hipSuccess) fprintf(stderr, "cooperative launch failed: %s (grid %d)\n", hipGetErrorString(e), grid);
}
```

```cpp
#include <hip/hip_runtime.h>
#include <hip/hip_cooperative_groups.h>
#include <cstdio>
#include <cstdint>
namespace cg = cooperative_groups;

constexpr int D = 1024, NB = 32, SEQ = 2048, NMETA = 16, LSEQ = 2064, PADR = 48, LP = 2112;
constexpr int MP = NB * LP;
constexpr int SB = 16, SN = 16, PAST = 1024, MS = SB * SN;
constexpr int MT = MP + MS;
constexpr int MTA = MT + 256;
constexpr int SXR = 1088;
constexpr int ER = MP + SB * SXR;
constexpr int NH = 8, INW = 4264, INWP = 4352, DFF = 2816, UPW = 5632;
constexpr int OFF_FF = 1536, OFF_CQ = 1544, OFF_CKV = 1928, OFF_KR = 2184, OFF_GATE = 2216;
constexpr float EPS = 1e-6f, LOG2E = 1.4426950408889634f;
constexpr size_t O_YP = 0, O_YS = O_YP + (size_t)NB * SEQ * D, O_KP = O_YS + (size_t)MS * D, O_VP = O_KP + (size_t)NB * LSEQ * 512, O_LFP = O_VP + (size_t)NB * LSEQ * 512,
                 O_CKVP = O_LFP + (size_t)NB * LSEQ * 8, O_KRP = O_CKVP + (size_t)NB * LSEQ * 256, O_CVP = O_KRP + (size_t)NB * LSEQ * 32, O_KS = O_CVP + (size_t)NB * 2 * UPW,
                 O_VS = O_KS + (size_t)MS * 512, O_LFS = O_VS + (size_t)MS * 512, O_CKVS = O_LFS + (size_t)MS * 8, O_KRS = O_CKVS + (size_t)MS * 256, O_CVS = O_KRS + (size_t)MS * 32,
                 O_END = O_CVS + (size_t)SB * 2 * UPW;
constexpr size_t AL(size_t x) { return (x + 4095) & ~(size_t)4095; }
constexpr size_t W_WIN = 0, W_WUQ = AL(W_WIN + (size_t)INWP * D * 2), W_WUKV = AL(W_WUQ + (size_t)768 * 384 * 2), W_WOC = AL(W_WUKV + (size_t)1024 * 256 * 2),
                 W_WOUT = AL(W_WOC + (size_t)1024 * 1024 * 2), W_WUP = AL(W_WOUT + (size_t)D * D * 2), W_WDN = AL(W_WUP + (size_t)UPW * D * 2), W_ROPE = AL(W_WDN + (size_t)D * DFF * 2),
                 W_SS2 = AL(W_ROPE + (size_t)LSEQ * 16 * 8), W_SS3 = AL(W_SS2 + (size_t)MT * 4), W_SSQ = AL(W_SS3 + (size_t)MT * 4), W_BAR = AL(W_SSQ + (size_t)MT * 4), W_XN = AL(W_BAR + 16384),
                 W_FQ = AL(W_XN + (size_t)MTA * D * 2), W_FK = AL(W_FQ + (size_t)MTA * 512 * 2), W_FV = AL(W_FK + (size_t)ER * 512 * 2), W_MISC = AL(W_FV + (size_t)ER * 512 * 2),
                 W_GATES = AL(W_MISC + (size_t)MT * 768 * 4), W_OCAT = AL(W_GATES + (size_t)MT * 2048 * 2), W_END = AL(W_OCAT + (size_t)MTA * 1024 * 2);
constexpr size_t W_CQ = W_OCAT  ;
constexpr size_t W_XN_END = W_XN;
static_assert(W_XN_END <= W_FQ, "XN-region overlay");
constexpr size_t W_MIX = W_XN;
constexpr size_t W_QMLA = W_MISC, W_CKVN = AL(W_QMLA + (size_t)MTA * 768 * 2), W_KR = AL(W_CKVN + (size_t)ER * 256 * 2), W_LOGF = AL(W_KR + (size_t)ER * 32 * 2), W_FB = AL(W_LOGF + (size_t)ER * 8 * 4);
static_assert(W_FB + (size_t)ER * 8 * 4 <= W_GATES, "MISC-region overlay");
constexpr size_t W_H1 = W_GATES, W_H1B = W_MISC, W_G = W_XN;
static_assert(W_G + (size_t)MT * DFF * 2 <= W_MISC, "G overlay");
static_assert((size_t)ER * 1024 * 2 <= (size_t)NB * SEQ * D * 4, "KVMLA lives in the y_prompt region of d_out until the last phase");

#define GAS __attribute__((address_space(1)))
#define LAS __attribute__((address_space(3)))
typedef unsigned short bf16;
typedef unsigned u32x4 __attribute__((ext_vector_type(4)));
typedef unsigned u32x2 __attribute__((ext_vector_type(2)));
typedef float f32x4 __attribute__((ext_vector_type(4)));
typedef float f32x2v __attribute__((ext_vector_type(2)));
typedef float f32x16 __attribute__((ext_vector_type(16)));
typedef short bf16x8 __attribute__((ext_vector_type(8)));
typedef short s16x4 __attribute__((ext_vector_type(4)));
typedef __bf16 bf16x2_t __attribute__((ext_vector_type(2)));
#define LDS_WAIT() asm volatile("s_waitcnt lgkmcnt(0)" ::: "memory")
__device__ __forceinline__ unsigned pk2(float lo, float hi) { f32x2v v = {lo, hi}; bf16x2_t b = __builtin_convertvector(v, bf16x2_t); return __builtin_bit_cast(unsigned, b); }
__device__ __forceinline__ float bflo(unsigned w) { return __uint_as_float(w << 16); }
__device__ __forceinline__ float bfhi(unsigned w) { return __uint_as_float(w & 0xffff0000u); }
__device__ __forceinline__ u32x4 pk8(f32x4 a, f32x4 b) { u32x4 w; w.x = pk2(a[0], a[1]); w.y = pk2(a[2], a[3]); w.z = pk2(b[0], b[1]); w.w = pk2(b[2], b[3]); return w; }
__device__ __forceinline__ float wave_sum(float v) {
#pragma unroll
    for (int o = 1; o < 64; o <<= 1) v += __shfl_xor(v, o);
    return v;
}
__device__ __forceinline__ int ext_row(int m) { return m < MP ? m : MP + ((m - MP) >> 4) * SXR + PAST + ((m - MP) & 15); }
__device__ __forceinline__ int out_row(int m) {
    if (m >= MP) return m < MT ? -1 - (m - MP) : (int)0x80000000;
    const int b = m / LP, tp = m - b * LP;
    return tp >= PADR ? b * LSEQ + (tp - PADR) : (int)0x80000000;
}
__device__ __forceinline__ int pos_of(int m) { if (m >= MP) return PAST + ((m - MP) & 15); const int tp = m % LP; return tp >= PADR ? tp - PADR : 0; }
struct KArgs { const float* in[25]; float* out; unsigned char* ws; };

namespace pg8 {
#define PG8_LAS __attribute__((address_space(3)))
typedef unsigned short bf16_t;
typedef short bf16x8 __attribute__((ext_vector_type(8)));
typedef float f32x4 __attribute__((ext_vector_type(4)));
typedef unsigned u32x4 __attribute__((ext_vector_type(4)));
constexpr int BM = 256, BK = 64, HALF = 128, HTB = HALF * BK * 2  , STAGE_BYTES = 8 * HTB, NXCD = 8, WGM = 8;

__host__ __device__ __forceinline__ int lds_byte(int r, int c) { const int st = (r >> 4) * 2 + (c >> 5), rr = r & 15, cc = c & 31, ob = rr * 64 + cc * 2; return st * 1024 + (ob ^ (((ob >> 9) & 1) << 5)); }
__host__ __device__ __forceinline__ void stage_rc(int b, int& R, int& C) { const int st = b / 1024, sb = b % 1024, swz = sb ^ (((sb >> 9) & 1) << 5); R = (st >> 1) * 16 + swz / 64; C = (st & 1) * 32 + (swz % 64) / 2; }
__host__ __device__ __forceinline__ int perm32(int rho) { const int n = rho >> 4, i = rho & 15; return 8 * (i >> 2) + 4 * n + (i & 3); }

struct Unit { int pm, pn; };
struct Gemm { const bf16_t* A; const bf16_t* Bt; int M, N, K; };

struct StaticOrder {
    int nM, nN, nwg, G, c, lim;
    __host__ __device__ void init(int M, int N, int G_, int c_) { nM = M / BM; nN = N / BM; nwg = nM * nN; G = G_; c = c_; lim = nwg; }
    __host__ __device__ void map(int L, Unit& u) const {
        int wgid = L; { const int q = nwg / NXCD, r = nwg % NXCD, xcd = wgid % NXCD, off = wgid / NXCD; wgid = (xcd < r ? xcd * (q + 1) : r * (q + 1) + (xcd - r) * q) + off; }
        const int nig = WGM * nN, gid = wgid / nig, fm = gid * WGM, gsz = (nM - fm) < WGM ? (nM - fm) : WGM;
        u.pm = fm + ((wgid % nig) % gsz); u.pn = (wgid % nig) / gsz;
    }
    __host__ __device__ bool next(int i, Unit& u) const { const long L = (long)i * G + c; if (L >= lim) return false; map((int)L, u); return true; }
    __device__ __forceinline__ void a_ready(const Unit&) const {}
    __device__ __forceinline__ void done(const Unit&) const {}
};


struct AMap { int perm, wrs, trows; };
#define PG8_ROW(ai, m) (u.pm * BM + (ai) * HALF + wr * 64 + (m) * 16 + fr)
#define PG8_EACH_AM _Pragma("unroll") for (int ai = 0; ai < 2; ++ai) _Pragma("unroll") for (int m = 0; m < 4; ++m)
#define PG8_RELANE do { int t_ = threadIdx.x; asm volatile("" : "+v"(t_)); fr = t_ & 15; fq = (t_ >> 4) & 3; const int w_ = __builtin_amdgcn_readfirstlane(t_ >> 6); wr = w_ >> 2; wc = w_ & 3; } while (0)
#define PG8_EACH_BJ _Pragma("unroll") for (int bj = 0; bj < 2; ++bj)
__device__ __forceinline__ f32x4 sig4(f32x4 x) { f32x4 r;
#pragma unroll
    for (int i = 0; i < 4; ++i) r[i] = __builtin_amdgcn_rcpf(1.f + __expf(-x[i])); return r; }
__device__ __forceinline__ f32x4 unlo(u32x2 w) { return (f32x4){::bflo(w.x), ::bfhi(w.x), ::bflo(w.y), ::bfhi(w.y)}; }
__device__ __forceinline__ float dpp_shr1(float v) { return __builtin_bit_cast(float, __builtin_amdgcn_update_dpp(0, __builtin_bit_cast(int, v), 0x111, 0xF, 0xF, false)); }

struct EpiPlain {
    static constexpr bool PERM = true, AFTER_DRAIN = false, MIDHOOK = false, PROBE2 = false;
    bf16_t* O; int ldc;
    __device__ __forceinline__ void operator()(const f32x4 (&acc)[2][2][4][2], const Unit& u, int wr, int wc, int fr, int fq) const { PG8_RELANE;
        const int colb = u.pn * BM + wc * 32 + 8 * fq;
        PG8_EACH_AM { bf16_t* p = O + (size_t)PG8_ROW(ai, m) * ldc + colb;
            PG8_EACH_BJ *(u32x4*)(p + bj * HALF) = ::pk8(acc[ai][bj][m][0], acc[ai][bj][m][1]); }
    }
};
struct EpiWin {
    static constexpr bool PERM = true, AFTER_DRAIN = false, MIDHOOK = false, PROBE2 = false;
    bf16_t *FQ, *FK, *FV, *GATES; float* out; bf16_t* CQ; float* SSQ; bf16_t *CKVN, *KR; float* LOGF; const float *rope, *gkv, *bforget; PG8_LAS float* xch;
    __device__ __forceinline__ void operator()(const f32x4 (&acc)[2][2][4][2], const Unit& u, int wr, int wc, int fr, int fq) const { PG8_RELANE;
        const int pn = u.pn, cw = wc * 32 + 8 * fq;
        if (pn == 8) {
            float ssr[8];
            PG8_EACH_AM { float ss = 0.f;
                PG8_EACH_BJ { const f32x4 a = acc[ai][bj][m][0], b = acc[ai][bj][m][1]; ss += (a[0] * a[0] + a[1] * a[1]) + (a[2] * a[2] + a[3] * a[3]) + (b[0] * b[0] + b[1] * b[1]) + (b[2] * b[2] + b[3] * b[3]); }
                ss += __shfl_xor(ss, 16); ss += __shfl_xor(ss, 32); ssr[ai * 4 + m] = ss;
                if (fq == 0) xch[(ai * HALF + wr * 64 + m * 16 + fr) * 4 + wc] = ss; }
            asm volatile("s_waitcnt lgkmcnt(0)" ::: "memory"); __builtin_amdgcn_s_barrier(); asm volatile("" ::: "memory");
            f32x4 gk[2][2];
            PG8_EACH_BJ { gk[bj][0] = *(const f32x4*)(gkv + bj * HALF + cw); gk[bj][1] = *(const f32x4*)(gkv + bj * HALF + cw + 4); }
            PG8_EACH_AM { const int row = PG8_ROW(ai, m); const PG8_LAS f32x4* xp = (const PG8_LAS f32x4*)(xch + (ai * HALF + wr * 64 + m * 16 + fr) * 4); const f32x4 s4 = *xp;
                const float rk = __builtin_amdgcn_rsqf(((s4[0] + s4[1]) + (s4[2] + s4[3])) * (1.f / 256.f) + EPS); const int er = ::ext_row(row), orow = ::out_row(row);
                float* o = nullptr; if (orow >= 0) o = out + O_CKVP + (size_t)orow * 256 + cw; else if (orow != (int)0x80000000) o = out + O_CKVS + (size_t)(-1 - orow) * 256 + cw;
                PG8_EACH_BJ { const f32x4 a = acc[ai][bj][m][0] * rk * gk[bj][0], b = acc[ai][bj][m][1] * rk * gk[bj][1];
                    *(u32x4*)(CKVN + (size_t)er * 256 + bj * HALF + cw) = ::pk8(a, b);
                    if (o) { *(f32x4*)(o + bj * HALF) = a; *(f32x4*)(o + bj * HALF + 4) = b; } }
                asm volatile("" ::: "memory"); }
            (void)ssr; return; }
        PG8_EACH_AM { const int row = PG8_ROW(ai, m);
            if (pn < 2) { bf16_t* p = FQ + (size_t)row * 512 + pn * 256 + cw;
                PG8_EACH_BJ *(u32x4*)(p + bj * HALF) = ::pk8(acc[ai][bj][m][0] * (0.125f * LOG2E), acc[ai][bj][m][1] * (0.125f * LOG2E)); }
            else if (pn < 6) { const int which = (pn - 2) >> 1, c = ((pn - 2) & 1) * 256 + cw; const int er = ::ext_row(row), orow = ::out_row(row);
                bf16_t* p = (which ? FV : FK) + (size_t)er * 512 + c; float* o = nullptr;
                if (orow < 0 && orow != (int)0x80000000) o = out + (which ? O_VS : O_KS) + (size_t)(-1 - orow) * 512 + c;
                PG8_EACH_BJ { *(u32x4*)(p + bj * HALF) = ::pk8(acc[ai][bj][m][0], acc[ai][bj][m][1]);
                    if (o) { *(f32x4*)(o + bj * HALF) = acc[ai][bj][m][0]; *(f32x4*)(o + bj * HALF + 4) = acc[ai][bj][m][1]; } } }
            else if (pn < 8) { float ss = 0.f;
                PG8_EACH_BJ { const f32x4 a = acc[ai][bj][m][0], b = acc[ai][bj][m][1];
                    if (pn == 6 || bj == 0) { *(u32x4*)(CQ + (size_t)row * 384 + (pn - 6) * 256 + bj * HALF + cw) = ::pk8(a, b);
                        ss += (a[0] * a[0] + a[1] * a[1]) + (a[2] * a[2] + a[3] * a[3]) + (b[0] * b[0] + b[1] * b[1]) + (b[2] * b[2] + b[3] * b[3]); }
                    else if (wc == 0) { const int er = ::ext_row(row), orow = ::out_row(row); const float* t = rope + ((size_t)::pos_of(row) * 16 + 8 * (fq & 1)) * 2; const float sg = (fq < 2) ? -1.f : 1.f;
                        const f32x4 t0 = *(const f32x4*)t, t1 = *(const f32x4*)(t + 4), t2 = *(const f32x4*)(t + 8), t3 = *(const f32x4*)(t + 12); f32x4 q0, q1, c0, c1;
#pragma unroll
                        for (int i = 0; i < 4; ++i) { q0[i] = __shfl_xor(a[i], 32); q1[i] = __shfl_xor(b[i], 32); }
                        c0[0] = a[0] * t0[0] + sg * q0[0] * t0[1]; c0[1] = a[1] * t0[2] + sg * q0[1] * t0[3]; c0[2] = a[2] * t1[0] + sg * q0[2] * t1[1]; c0[3] = a[3] * t1[2] + sg * q0[3] * t1[3];
                        c1[0] = b[0] * t2[0] + sg * q1[0] * t2[1]; c1[1] = b[1] * t2[2] + sg * q1[1] * t2[3]; c1[2] = b[2] * t3[0] + sg * q1[2] * t3[1]; c1[3] = b[3] * t3[2] + sg * q1[3] * t3[3];
                        *(u32x4*)(KR + (size_t)er * 32 + 8 * fq) = ::pk8(c0, c1);
                        float* o = nullptr; if (orow >= 0) o = out + O_KRP + (size_t)orow * 32 + 8 * fq; else if (orow != (int)0x80000000) o = out + O_KRS + (size_t)(-1 - orow) * 32 + 8 * fq;
                        if (o) { *(f32x4*)o = c0; *(f32x4*)(o + 4) = c1; } }
                    else if (wc == 1 && fq == 0) { const int er = ::ext_row(row), orow = ::out_row(row); f32x4 c0, c1; const f32x4 bf0 = *(const f32x4*)bforget, bf1 = *(const f32x4*)(bforget + 4);
#pragma unroll
                        for (int i = 0; i < 4; ++i) { const float z0 = a[i] + bf0[i], z1 = b[i] + bf1[i]; c0[i] = fminf(z0, 0.f) - log1pf(__expf(-fabsf(z0))); c1[i] = fminf(z1, 0.f) - log1pf(__expf(-fabsf(z1))); }
                        *(f32x4*)(LOGF + (size_t)er * 8) = c0; *(f32x4*)(LOGF + (size_t)er * 8 + 4) = c1;
                        float* o = nullptr; if (orow >= 0) o = out + O_LFP + (size_t)orow * 8; else if (orow != (int)0x80000000) o = out + O_LFS + (size_t)(-1 - orow) * 8;
                        if (o) { *(f32x4*)o = c0; *(f32x4*)(o + 4) = c1; } } }
                ss += __shfl_xor(ss, 16); ss += __shfl_xor(ss, 32); if (fq == 0) unsafeAtomicAdd(SSQ + row, ss); }
            else { bf16_t* p = GATES + (size_t)row * 2048 + (pn - 9) * 256 + cw;
                PG8_EACH_BJ *(u32x4*)(p + bj * HALF) = ::pk8(sig4(acc[ai][bj][m][0]), sig4(acc[ai][bj][m][1])); }
            asm volatile("" ::: "memory");
        }
    }
};
struct EpiQ {
    static constexpr bool PERM = true, AFTER_DRAIN = false, MIDHOOK = false, PROBE2 = false;
    bf16_t* Q; const float* rope; const float* ssq;
    __device__ __forceinline__ void operator()(const f32x4 (&acc)[2][2][4][2], const Unit& u, int wr, int wc, int fr, int fq) const { PG8_RELANE;
        PG8_EACH_BJ { const int g32 = u.pn * 8 + bj * 4 + wc; const bool rp = (g32 % 3) == 2; const float sg = (fq < 2) ? -1.f : 1.f;
            PG8_EACH_AM { const int row = PG8_ROW(ai, m); const float rq = __builtin_amdgcn_rsqf(ssq[row] * (1.f / 384.f) + EPS) * (0.10206207261596575f * LOG2E);
                f32x4 v0 = acc[ai][bj][m][0] * rq, v1 = acc[ai][bj][m][1] * rq;
                if (rp) { const float* t = rope + ((size_t)::pos_of(row) * 16 + 8 * (fq & 1)) * 2;
                    const f32x4 t0 = *(const f32x4*)t, t1 = *(const f32x4*)(t + 4), t2 = *(const f32x4*)(t + 8), t3 = *(const f32x4*)(t + 12);
                    f32x4 q0, q1;
#pragma unroll
                    for (int i = 0; i < 4; ++i) { q0[i] = __shfl_xor(v0[i], 32); q1[i] = __shfl_xor(v1[i], 32); }
                    v0[0] = v0[0] * t0[0] + sg * q0[0] * t0[1]; v0[1] = v0[1] * t0[2] + sg * q0[1] * t0[3]; v0[2] = v0[2] * t1[0] + sg * q0[2] * t1[1]; v0[3] = v0[3] * t1[2] + sg * q0[3] * t1[3];
                    v1[0] = v1[0] * t2[0] + sg * q1[0] * t2[1]; v1[1] = v1[1] * t2[2] + sg * q1[1] * t2[3]; v1[2] = v1[2] * t3[0] + sg * q1[2] * t3[1]; v1[3] = v1[3] * t3[2] + sg * q1[3] * t3[3]; }
                *(u32x4*)(Q + (size_t)row * 768 + u.pn * BM + bj * HALF + wc * 32 + 8 * fq) = ::pk8(v0, v1); asm volatile("" ::: "memory"); } }
    }
};
struct EpiMixCat {
    static constexpr bool PERM = true, AFTER_DRAIN = false, MIDHOOK = true, PROBE2 = false;
    bf16_t* MIX; const bf16_t* GATES;
    __device__ __forceinline__ void mid(f32x4 (&acc)[2][2][4][2], const Unit& u, int wr, int wc, int fr, int fq) const { PG8_RELANE;
        const int colb = u.pn * BM + wc * 32 + 8 * fq;
        PG8_EACH_AM { const int row = PG8_ROW(ai, m);
            PG8_EACH_BJ { const bf16_t* gp = GATES + (size_t)row * 2048 + colb + bj * HALF; const u32x4 ga = *(const u32x4*)gp, gb = *(const u32x4*)(gp + 1024);
                f32x4 a0 = unlo((u32x2){ga.x, ga.y}), a1 = unlo((u32x2){ga.z, ga.w}), b0 = unlo((u32x2){gb.x, gb.y}), b1 = unlo((u32x2){gb.z, gb.w});
#pragma unroll
                for (int i = 0; i < 4; ++i) { a0[i] *= __builtin_amdgcn_rcpf(fmaxf(b0[i], 1e-30f)); a1[i] *= __builtin_amdgcn_rcpf(fmaxf(b1[i], 1e-30f)); }
                acc[ai][bj][m][0] *= a0; acc[ai][bj][m][1] *= a1; }
            asm volatile("" ::: "memory"); }
    }
    __device__ __forceinline__ void operator()(const f32x4 (&acc)[2][2][4][2], const Unit& u, int wr, int wc, int fr, int fq) const { PG8_RELANE;
        const int colb = u.pn * BM + wc * 32 + 8 * fq;
        PG8_EACH_AM { const int row = PG8_ROW(ai, m);
            PG8_EACH_BJ { const int col = colb + bj * HALF; const u32x4 gb = *(const u32x4*)(GATES + (size_t)row * 2048 + 1024 + col);
                f32x4 b0 = unlo((u32x2){gb.x, gb.y}), b1 = unlo((u32x2){gb.z, gb.w});
#pragma unroll
                for (int i = 0; i < 4; ++i) { b0[i] = fmaxf(b0[i], 1e-30f); b1[i] = fmaxf(b1[i], 1e-30f); }
                *(u32x4*)(MIX + (size_t)row * 1024 + col) = ::pk8(acc[ai][bj][m][0] * b0, acc[ai][bj][m][1] * b1); } }
    }
};
struct EpiH1 {
    static constexpr bool PERM = true, AFTER_DRAIN = false, MIDHOOK = false, PROBE2 = false;
    const float *xp, *meta, *xs; float* H1; bf16_t* H1B; float* SS;
    __device__ __forceinline__ void operator()(const f32x4 (&acc)[2][2][4][2], const Unit& u, int wr, int wc, int fr, int fq) const { PG8_RELANE;
        const int colb = u.pn * BM + wc * 32 + 8 * fq;
        PG8_EACH_AM { const int row = PG8_ROW(ai, m); const float* xr = nullptr;
            if (row >= MP) xr = xs + (size_t)(row - MP) * D; else { const int b = row / LP, tp = row - b * LP; if (tp >= 64) xr = xp + ((size_t)b * SEQ + (tp - 64)) * D; else if (tp >= PADR) xr = meta + (size_t)(tp - PADR) * D; }
            float ss = 0.f;
            PG8_EACH_BJ { const int col = colb + bj * HALF; f32x4 a = acc[ai][bj][m][0], b = acc[ai][bj][m][1];
                if (xr) { a += *(const f32x4*)(xr + col); b += *(const f32x4*)(xr + col + 4); }
                *(u32x4*)(H1B + (size_t)row * D + col) = ::pk8(a, b);
                ss += (a[0] * a[0] + a[1] * a[1]) + (a[2] * a[2] + a[3] * a[3]) + (b[0] * b[0] + b[1] * b[1]) + (b[2] * b[2] + b[3] * b[3]); }
            ss += __shfl_xor(ss, 16); ss += __shfl_xor(ss, 32);
            if (fq == 0) unsafeAtomicAdd(SS + row, ss); }
    }
};
struct EpiH2 {
    static constexpr bool PERM = true, AFTER_DRAIN = false, MIDHOOK = false, PROBE2 = false;
    bf16_t* HB; float* SS;
    __device__ __forceinline__ void operator()(const f32x4 (&acc)[2][2][4][2], const Unit& u, int wr, int wc, int fr, int fq) const { PG8_RELANE;
        const int colb = u.pn * BM + wc * 32 + 8 * fq;
        PG8_EACH_AM { const int row = PG8_ROW(ai, m); float ss = 0.f;
            PG8_EACH_BJ { bf16_t* p = HB + (size_t)row * D + colb + bj * HALF; const u32x4 o = *(const u32x4*)p;
                const f32x4 a = acc[ai][bj][m][0] + unlo((u32x2){o.x, o.y}), b = acc[ai][bj][m][1] + unlo((u32x2){o.z, o.w});
                *(u32x4*)p = ::pk8(a, b);
                ss += (a[0] * a[0] + a[1] * a[1]) + (a[2] * a[2] + a[3] * a[3]) + (b[0] * b[0] + b[1] * b[1]) + (b[2] * b[2] + b[3] * b[3]); }
            ss += __shfl_xor(ss, 16); ss += __shfl_xor(ss, 32);
            if (fq == 0) unsafeAtomicAdd(SS + row, ss); }
    }
};
template <bool SAMPLE> struct EpiConv {
    static constexpr bool PERM = true, AFTER_DRAIN = false, MIDHOOK = false, PROBE2 = true;
    bf16_t* G; const float* ss2; const float* convw; const float* convb; const float* state; float* out; int wrs;
    __device__ __forceinline__ void operator()(const f32x4 (&acc)[2][2][4][2], const Unit& u, int wr, int wc, int fr, int fq) const { PG8_RELANE;
        const int runbase = (SAMPLE ? MP : u.pm * 252) + wrs * wr, base = runbase + 8 * fr;
        float rs[8]; unsigned okm = 0u;
#pragma unroll
        for (int j = 0; j < 8; ++j) { const int tok = base + j;
            if (SAMPLE) { rs[j] = __builtin_amdgcn_rsqf(ss2[tok] * (1.f / D) + EPS); okm |= 1u << j; }
            else { const int tc = tok < MT ? tok : MT - 1; const bool v = tok < MP && (tc % LP) >= PADR; rs[j] = v ? __builtin_amdgcn_rsqf(ss2[tc] * (1.f / D) + EPS) : 0.f;
                if (tok < MP && (fr > 0 || j >= 2)) okm |= 1u << j; } }
        const int chb = u.pn * 128 + wc * 32 + 8 * fq;
        const int sb = 8 * wr + (fr >> 1);
        int eb = -1, etok = 0;
        if (!SAMPLE) { const int b = runbase / LP; etok = b * LP + LP - 2; if (b < NB && etok < runbase + 128) eb = b; }
        unsigned char* gb = (unsigned char*)G + (size_t)(unsigned)base * (DFF * 2);
#pragma unroll
        for (int n = 0; n < 2; ++n) { const int ch = chb + 4 * n; f32x4 cg[8];
#pragma unroll
            for (int bj = 0; bj < 2; ++bj) { const int cx = bj * DFF + ch;
                const f32x4 cb = *(const f32x4*)(convb + cx), w0 = *(const f32x4*)(convw + cx), w1 = *(const f32x4*)(convw + UPW + cx), w2 = *(const f32x4*)(convw + 2 * UPW + cx);
                f32x4 p1, p2;
                { const f32x4 u7 = acc[1][bj][3][n] * rs[7], u6 = acc[1][bj][2][n] * rs[6];
#pragma unroll
                    for (int e2 = 0; e2 < 4; ++e2) { p1[e2] = dpp_shr1(u7[e2]); p2[e2] = dpp_shr1(u6[e2]); }
                    if (SAMPLE) { if (fr & 1) { *(f32x4*)(out + O_CVS + ((size_t)sb * 2) * UPW + cx) = u6; *(f32x4*)(out + O_CVS + ((size_t)sb * 2 + 1) * UPW + cx) = u7; }
                        else { p1 = *(const f32x4*)(state + ((size_t)sb * 2 + 1) * UPW + cx); p2 = *(const f32x4*)(state + ((size_t)sb * 2) * UPW + cx); } } }
                if (!SAMPLE && eb >= 0) {
#pragma unroll
                    for (int j = 0; j < 8; ++j) { const int k = base + j - etok; if ((k == 0 || k == 1) && ((okm >> j) & 1u)) *(f32x4*)(out + O_CVP + ((size_t)eb * 2 + k) * UPW + cx) = acc[j >> 2][bj][j & 3][n] * rs[j]; } }
                f32x4 um2 = p2, um1 = p1;
#pragma unroll
                for (int j = 0; j < 8; ++j) { const f32x4 uj = acc[j >> 2][bj][j & 3][n] * rs[j];
                    const f32x4 c = cb + w0 * um2 + w1 * um1 + w2 * uj; um2 = um1; um1 = uj;
                    if (bj == 0) cg[j] = c;
                    else { const f32x4 o = cg[j] * sig4(cg[j]) * c;
                        if ((okm >> j) & 1u) *(u32x2*)(gb + j * (DFF * 2) + ch * 2) = (u32x2){::pk2(o[0], o[1]), ::pk2(o[2], o[3])}; } }
                asm volatile("" ::: "memory");
            } }
    }
};
template <class Epi, class Sched, bool ALIGN_EPI = false, bool SP2 = false>
__device__ __forceinline__ void gemm_phase(PG8_LAS unsigned char* lds, const Gemm g, const Sched& S, const Epi& E, const AMap am) {
    int tid_ = threadIdx.x; asm volatile("" : "+v"(tid_));
    const int tid = tid_, wid = __builtin_amdgcn_readfirstlane(tid >> 6), lane = tid & 63, wr = wid >> 2, wc = wid & 3, fr = lane & 15, fq = lane >> 4;
    int K_ = g.K; asm volatile("" : "+s"(K_)); const int K = K_, nt = K / BK;
    unsigned voffA[2], voffB[2];
#pragma unroll
    for (int i = 0; i < 2; ++i) { int R, C; stage_rc(tid * 16 + i * 8192, R, C); const int Rb = Epi::PERM ? ((R & ~31) + perm32(R & 31)) : R;
        voffA[i] = (unsigned)((am.perm ? (am.wrs * (R >> 6) + 8 * (R & 15) + ((R >> 4) & 3)) : R) * K + C) * 2u; voffB[i] = (unsigned)(Rb * K + C) * 2u; }
    const size_t kstep = (size_t)(BK * 2);
    const size_t hstep = (size_t)HALF * K * 2;
    const size_t tstep = 2 * hstep;
    const size_t hstepA = am.perm ? (size_t)4 * K * 2 : hstep; const size_t tstepA = (size_t)am.trows * K * 2;
    const unsigned ldsw = (unsigned)wid * 1024u;
    const int aoff = lds_byte(wr * 64 + fr, fq * 8), boff = lds_byte(wc * 32 + fr, fq * 8);
#define PG8_SA(b, h) (((b) * 2 + (h)) * HTB)
#define PG8_SB(b, h) ((4 + (b) * 2 + (h)) * HTB)
#define PG8_STAGE(bufoff, gbase, voff) do { _Pragma("unroll") for (int _i = 0; _i < 2; ++_i) \
        __builtin_amdgcn_global_load_lds((const unsigned*)((const char*)(gbase) + (voff)[_i]), (PG8_LAS unsigned*)(lds + (bufoff) + ldsw + _i * 8192), 16, 0, 0); } while (0)
#define PG8_LDA(dst, b, h) do { _Pragma("unroll") for (int m = 0; m < 4; ++m) _Pragma("unroll") for (int k = 0; k < 2; ++k) dst[m][k] = *(const PG8_LAS bf16x8*)(lds + PG8_SA(b, h) + aoff + m * 2048 + k * 1024); } while (0)
#define PG8_LDB(dst, b, h) do { _Pragma("unroll") for (int n = 0; n < 2; ++n) _Pragma("unroll") for (int k = 0; k < 2; ++k) dst[n][k] = *(const PG8_LAS bf16x8*)(lds + PG8_SB(b, h) + boff + n * 2048 + k * 1024); } while (0)
#define PG8_MMA(ai, bj, At, Bt) do { __builtin_amdgcn_s_setprio(1); _Pragma("unroll") for (int m = 0; m < 4; ++m) _Pragma("unroll") for (int n = 0; n < 2; ++n) _Pragma("unroll") for (int k = 0; k < 2; ++k) \
        acc[ai][bj][m][n] = __builtin_amdgcn_mfma_f32_16x16x32_bf16(Bt[n][k], At[m][k], acc[ai][bj][m][n], 0, 0, 0); __builtin_amdgcn_s_setprio(0); } while (0)
#define PG8_WAIT_V(n) asm volatile("s_waitcnt vmcnt(" #n ")" ::: "memory")
#define PG8_WAIT_L(n) asm volatile("s_waitcnt lgkmcnt(" #n ")" ::: "memory")
#define PG8_BAR __builtin_amdgcn_s_barrier()
#define PG8_SCHED __builtin_amdgcn_sched_barrier(0)
    Unit cur, nxt; int ui = 0;
    if (!S.next(0, cur)) return;
    f32x4 acc[2][2][4][2];
#pragma unroll
    for (int a = 0; a < 2; ++a)
#pragma unroll
        for (int b = 0; b < 2; ++b)
#pragma unroll
            for (int m = 0; m < 4; ++m)
#pragma unroll
                for (int n = 0; n < 2; ++n) acc[a][b][m][n] = (f32x4){0.f, 0.f, 0.f, 0.f};
    bf16x8 At[4][2], B0[2][2], B1[2][2];
    const char* cA = (const char*)g.A + (size_t)cur.pm * tstepA; const char* cB = (const char*)g.Bt + (size_t)cur.pn * tstep;
    S.a_ready(cur);
    if constexpr (SP2) {
        PG8_STAGE(PG8_SB(0, 0), cB, voffB); PG8_STAGE(PG8_SB(0, 1), cB + hstep, voffB); PG8_STAGE(PG8_SA(0, 0), cA, voffA); PG8_STAGE(PG8_SA(0, 1), cA + hstepA, voffA);
        if (wr == 1) PG8_BAR;
        PG8_WAIT_V(2); PG8_BAR;
        PG8_STAGE(PG8_SB(1, 0), cB + kstep, voffB); PG8_STAGE(PG8_SA(1, 0), cA + kstep, voffA); PG8_STAGE(PG8_SB(1, 1), cB + hstep + kstep, voffB);
        PG8_WAIT_V(6); PG8_BAR;
    } else {
        PG8_STAGE(PG8_SB(0, 0), cB, voffB); PG8_STAGE(PG8_SA(0, 0), cA, voffA); PG8_STAGE(PG8_SB(0, 1), cB + hstep, voffB); PG8_STAGE(PG8_SA(0, 1), cA + hstepA, voffA);
        if (wr == 1) PG8_BAR;
        PG8_WAIT_V(4); PG8_BAR;
        PG8_STAGE(PG8_SB(1, 0), cB + kstep, voffB); PG8_STAGE(PG8_SA(1, 0), cA + kstep, voffA); PG8_STAGE(PG8_SB(1, 1), cB + hstep + kstep, voffB);
        PG8_WAIT_V(6); PG8_BAR;
    }
    for (;;) {
        const bool has_next = S.next(ui + 1, nxt);
        const char* nA = has_next ? (const char*)g.A + (size_t)nxt.pm * tstepA : cA; const char* nB = has_next ? (const char*)g.Bt + (size_t)nxt.pn * tstep : cB;
        for (int t = 0; t < nt; t += 2) {
            const bool last = (t == nt - 2);
            const char* a1 = cA + (size_t)(t + 1) * kstep;
            const char* a2 = last ? nA : cA + (size_t)(t + 2) * kstep; const char* b2 = last ? nB : cB + (size_t)(t + 2) * kstep;
            const char* a3 = a2 + kstep; const char* b3 = b2 + kstep;
            if (last && has_next) S.a_ready(nxt);
            if constexpr (SP2) {
            PG8_LDB(B0, 0, 0); PG8_LDB(B1, 0, 1); PG8_SCHED; PG8_LDA(At, 0, 0); PG8_STAGE(PG8_SA(1, 1), a1 + hstepA, voffA);
            PG8_WAIT_V(8); PG8_WAIT_L(0); PG8_BAR; PG8_MMA(0, 0, At, B0); PG8_MMA(0, 1, At, B1); PG8_BAR; PG8_SCHED;
            PG8_LDA(At, 0, 1); PG8_STAGE(PG8_SB(0, 0), b2, voffB); PG8_STAGE(PG8_SB(0, 1), b2 + hstep, voffB); PG8_STAGE(PG8_SA(0, 0), a2, voffA);
            PG8_WAIT_V(8); PG8_WAIT_L(0); PG8_BAR; PG8_MMA(1, 0, At, B0); PG8_MMA(1, 1, At, B1); PG8_BAR; PG8_SCHED;
            PG8_LDB(B0, 1, 0); PG8_LDB(B1, 1, 1); PG8_SCHED; PG8_LDA(At, 1, 0); PG8_STAGE(PG8_SA(0, 1), a2 + hstepA, voffA);
            PG8_WAIT_V(8); PG8_WAIT_L(0); PG8_BAR; PG8_MMA(0, 0, At, B0); PG8_MMA(0, 1, At, B1); PG8_BAR; PG8_SCHED;
            PG8_LDA(At, 1, 1); PG8_STAGE(PG8_SB(1, 0), b3, voffB); PG8_STAGE(PG8_SB(1, 1), b3 + hstep, voffB); PG8_STAGE(PG8_SA(1, 0), a3, voffA);
            PG8_WAIT_V(8); PG8_WAIT_L(0); PG8_BAR; PG8_MMA(1, 0, At, B0); PG8_MMA(1, 1, At, B1); PG8_BAR; PG8_SCHED;
            if constexpr (Epi::MIDHOOK) { if (t + 2 == nt / 2) E.mid(acc, cur, wr, wc, fr, fq); }
            } else {
            PG8_LDB(B0, 0, 0); PG8_SCHED; PG8_LDA(At, 0, 0); PG8_STAGE(PG8_SA(1, 1), a1 + hstepA, voffA);
            PG8_WAIT_L(8); PG8_BAR; PG8_WAIT_L(0); PG8_MMA(0, 0, At, B0); PG8_BAR; PG8_SCHED;
            PG8_LDB(B1, 0, 1); PG8_STAGE(PG8_SB(0, 0), b2, voffB);
            PG8_BAR; PG8_WAIT_L(0); PG8_MMA(0, 1, At, B1); PG8_BAR;
            PG8_LDA(At, 0, 1); PG8_STAGE(PG8_SA(0, 0), a2, voffA);
            PG8_BAR; PG8_WAIT_L(0); PG8_MMA(1, 0, At, B0); PG8_BAR; PG8_SCHED;
            PG8_STAGE(PG8_SB(0, 1), b2 + hstep, voffB);
            PG8_WAIT_V(6); PG8_BAR; PG8_MMA(1, 1, At, B1); PG8_BAR;
            PG8_LDB(B0, 1, 0); PG8_SCHED; PG8_LDA(At, 1, 0); PG8_STAGE(PG8_SA(0, 1), a2 + hstepA, voffA);
            PG8_WAIT_L(8); PG8_BAR; PG8_WAIT_L(0); PG8_MMA(0, 0, At, B0); PG8_BAR; PG8_SCHED;
            PG8_LDB(B1, 1, 1); PG8_STAGE(PG8_SB(1, 0), b3, voffB);
            PG8_BAR; PG8_WAIT_L(0); PG8_MMA(0, 1, At, B1); PG8_BAR;
            PG8_LDA(At, 1, 1); PG8_STAGE(PG8_SA(1, 0), a3, voffA);
            PG8_BAR; PG8_WAIT_L(0); PG8_MMA(1, 0, At, B0); PG8_BAR; PG8_SCHED;
            PG8_STAGE(PG8_SB(1, 1), b3 + hstep, voffB);
            PG8_WAIT_V(6); PG8_BAR; PG8_MMA(1, 1, At, B1); PG8_BAR;
            }
        }
        if constexpr (ALIGN_EPI) { if (wr == 0) PG8_BAR; }
        if constexpr (!Epi::AFTER_DRAIN) { E(acc, cur, wr, wc, fr, fq);
#ifdef PROBE_EPI2
            if constexpr (Epi::PROBE2) { asm volatile("" ::: "memory"); E(acc, cur, wr, wc, fr, fq); }
#endif
            S.done(cur); }
        if (!has_next) break;
#pragma unroll
        for (int a = 0; a < 2; ++a)
#pragma unroll
            for (int b = 0; b < 2; ++b)
#pragma unroll
                for (int m = 0; m < 4; ++m)
#pragma unroll
                    for (int n = 0; n < 2; ++n) acc[a][b][m][n] = (f32x4){0.f, 0.f, 0.f, 0.f};
        cur = nxt; cA = nA; cB = nB; ++ui;
        if constexpr (ALIGN_EPI) { if (wr == 1) PG8_BAR; }
    }
    PG8_WAIT_V(0);
    if constexpr (!ALIGN_EPI) { if (wr == 0) PG8_BAR; }
    PG8_BAR;
    if constexpr (Epi::AFTER_DRAIN) { E.fused(acc, cur, wr, wc, fr, fq, lds, wid, lane); S.done(cur); }
#undef PG8_SA
#undef PG8_SB
#undef PG8_STAGE
#undef PG8_LDA
#undef PG8_LDB
#undef PG8_MMA
#undef PG8_WAIT_V
#undef PG8_WAIT_L
#undef PG8_BAR
#undef PG8_SCHED
}
}

__device__ __forceinline__ void tr_item(const float* W, int Nsrc, int K, bf16* WT, int drow0, int scol0, int nvalid, const float* kscale, LAS float* scr, int kb, int lane, int koff = 0) {
    const int k0 = 64 * kb;
#pragma unroll 16
    for (int i = 0; i < 32; ++i) { const int kk = 2 * i + (lane >> 5), c = lane & 31; float v = 0.f;
        if (c < nvalid) v = W[(size_t)(k0 + kk) * Nsrc + scol0 + c];
        if (kscale) v *= kscale[k0 + kk];
        scr[kk * 33 + c] = v; }
    LDS_WAIT(); asm volatile("" ::: "memory");
    const int c8 = lane & 7;
#pragma unroll
    for (int j = 0; j < 4; ++j) { const int n = (lane >> 3) + 8 * j; const LAS float* s = scr + (8 * c8) * 33 + n;
        u32x4 o; o.x = pk2(s[0 * 33], s[1 * 33]); o.y = pk2(s[2 * 33], s[3 * 33]); o.z = pk2(s[4 * 33], s[5 * 33]); o.w = pk2(s[6 * 33], s[7 * 33]);
        *(u32x4*)(WT + (size_t)(drow0 + n) * K + koff + k0 + 8 * c8) = o; }
    LDS_WAIT(); asm volatile("" ::: "memory");
}
__device__ __forceinline__ const float* x_row_ptr(int m, const float* xp, const float* meta, const float* xs) {
    if (m >= MP) return xs + (size_t)(m - MP) * D;
    const int b = m / LP, tp = m - b * LP;
    if (tp >= 64) return xp + ((size_t)b * SEQ + (tp - 64)) * D;
    if (tp >= PADR) return meta + (size_t)(tp - PADR) * D;
    return nullptr;
}
__device__ __forceinline__ void p0_prologue(const KArgs& a, LAS unsigned char* lds, int gw, int NGW, int wave, int lane, int gtid, int NT) {
    unsigned char* ws = a.ws;
    LAS float* scr = (LAS float*)(lds + wave * 16384);
    constexpr int I0 = 16 * 136, I1 = I0 + 6 * 24, I2 = I1 + 4 * 32, I3 = I2 + 8 * 32, I4 = I3 + 8 * 32, I5 = I4 + 16 * 32, I6 = I5 + 16 * 176, I7 = I6 + 44 * 32;
    for (int it = gw; it < I7; it += NGW) {
        if (it < I0) { const int kb = it / 136, g = it % 136, n0 = 32 * g; int sc, nv = 32;
            if (n0 < 1536) sc = n0;
            else if (n0 < 2304) { const int j = n0 - 1536; if (j < 384) sc = OFF_CQ + j; else if (j == 384) sc = OFF_KR; else if (j == 416) { sc = OFF_FF; nv = 8; } else if (j < 512) { sc = 0; nv = 0; } else sc = OFF_CKV + (j - 512); }
            else sc = OFF_GATE + (n0 - 2304);
            tr_item(a.in[10], INW, D, (bf16*)(ws + W_WIN), n0, sc, nv, nullptr, scr, kb, lane); }
        else if (it < I1) { const int r = it - I0, kb = r / 24, g = r % 24; tr_item(a.in[13], 768, 384, (bf16*)(ws + W_WUQ), 32 * g, 32 * g, 32, a.in[12], scr, kb, lane); }
        else if (it < I2) { const int r = it - I1, kb = r / 32, g = r % 32; tr_item(a.in[15], 1024, 256, (bf16*)(ws + W_WUKV), 32 * g, 32 * g, 32, nullptr, scr, kb, lane); }
        else if (it < I3) { const int r = it - I2, kb = r / 32, g = r % 32; tr_item(a.in[16], 1024, 1024, (bf16*)(ws + W_WOC), 32 * g, 32 * g, 32, nullptr, scr, kb, lane, 0); }
        else if (it < I4) { const int r = it - I3, kb = r / 32, g = r % 32; tr_item(a.in[17], 1024, 1024, (bf16*)(ws + W_WOC), 32 * g, 32 * g, 32, nullptr, scr, kb, lane, 512); }
        else if (it < I5) { const int r = it - I4, kb = r / 32, g = r % 32; tr_item(a.in[18], 1024, 1024, (bf16*)(ws + W_WOUT), 32 * g, 32 * g, 32, nullptr, scr, kb, lane); }
        else if (it < I6) { const int r = it - I5, kb = r / 176, g = r % 176, n0 = 32 * g, pn = n0 >> 8, jj = n0 & 255, bj = jj >> 7, ch = 128 * pn + (jj & 127);
            tr_item(a.in[20], UPW, D, (bf16*)(ws + W_WUP), n0, bj * DFF + ch, 32, a.in[19], scr, kb, lane); }
        else { const int r = it - I6, kb = r / 32, g = r % 32; tr_item(a.in[23], 1024, DFF, (bf16*)(ws + W_WDN), 32 * g, 32 * g, 32, nullptr, scr, kb, lane); }
    }
    { const float* gm = a.in[9]; f32x4 gv[4];
#pragma unroll
        for (int j = 0; j < 4; ++j) gv[j] = *(const f32x4*)(gm + 4 * lane + 256 * j);
        bf16* XN = (bf16*)(ws + W_XN);
        for (int m0 = 4 * gw; m0 < MT; m0 += 4 * NGW) {
            f32x4 v[4][4]; float s[4];
#pragma unroll
            for (int q = 0; q < 4; ++q) { const float* xr = x_row_ptr(m0 + q, a.in[0], a.in[8], a.in[1]);
#pragma unroll
                for (int j = 0; j < 4; ++j) v[q][j] = xr ? *(const f32x4*)(xr + 4 * lane + 256 * j) : (f32x4){0.f, 0.f, 0.f, 0.f}; }
#pragma unroll
            for (int q = 0; q < 4; ++q) { s[q] = 0.f;
#pragma unroll
                for (int j = 0; j < 4; ++j) s[q] += (v[q][j][0] * v[q][j][0] + v[q][j][1] * v[q][j][1]) + (v[q][j][2] * v[q][j][2] + v[q][j][3] * v[q][j][3]); }
#pragma unroll
            for (int q = 0; q < 4; ++q) { const float r = __builtin_amdgcn_rsqf(wave_sum(s[q]) * (1.f / D) + EPS);
#pragma unroll
                for (int j = 0; j < 4; ++j) { const f32x4 o = v[q][j] * r * gv[j]; *(u32x2*)(XN + (size_t)(m0 + q) * D + 4 * lane + 256 * j) = (u32x2){pk2(o[0], o[1]), pk2(o[2], o[3])}; } } } }
    { bf16* FK = (bf16*)(ws + W_FK); bf16* FV = (bf16*)(ws + W_FV);
        for (int t0 = gw; t0 < SB * SXR; t0 += 2 * NGW) {
            u32x4 k[2], v[2]; bool wr_[2];
#pragma unroll
            for (int q = 0; q < 2; ++q) { const int t = t0 + q * NGW; k[q] = (u32x4){0u, 0u, 0u, 0u}; v[q] = k[q]; wr_[q] = false;
                if (t < SB * SXR) { const int sb = t / SXR, j = t - sb * SXR; wr_[q] = !(j >= PAST && j < PAST + SN);
                    if (j < PAST) { const size_t src = ((size_t)sb * PAST + j) * 512 + 8 * lane; k[q] = pk8(*(const f32x4*)(a.in[2] + src), *(const f32x4*)(a.in[2] + src + 4)); v[q] = pk8(*(const f32x4*)(a.in[3] + src), *(const f32x4*)(a.in[3] + src + 4)); } } }
#pragma unroll
            for (int q = 0; q < 2; ++q) if (wr_[q]) { const size_t er = (size_t)(MP + t0 + q * NGW) * 512 + 8 * lane; *(u32x4*)(FK + er) = k[q]; *(u32x4*)(FV + er) = v[q]; } } }
    { bf16* CKVN = (bf16*)(ws + W_CKVN); bf16* KR = (bf16*)(ws + W_KR); float* LOGF = (float*)(ws + W_LOGF);
    for (int t = gw; t < SB * SXR; t += NGW) { const int sb = t / SXR, j = t - sb * SXR; if (j >= PAST && j < PAST + SN) continue;
        const size_t er = (size_t)(MP + t); const bool c = j < PAST; const size_t sr = (size_t)sb * PAST + j;
        { f32x4 v = {0.f, 0.f, 0.f, 0.f}; if (c) v = *(const f32x4*)(a.in[5] + sr * 256 + 4 * lane); *(u32x2*)(CKVN + er * 256 + 4 * lane) = (u32x2){pk2(v[0], v[1]), pk2(v[2], v[3])}; }
        if (lane < 8) { f32x4 v = {0.f, 0.f, 0.f, 0.f}; if (c) v = *(const f32x4*)(a.in[6] + sr * 32 + 4 * lane); *(u32x2*)(KR + er * 32 + 4 * lane) = (u32x2){pk2(v[0], v[1]), pk2(v[2], v[3])}; }
        if (lane < 2) { f32x4 v = {0.f, 0.f, 0.f, 0.f}; if (c) v = *(const f32x4*)(a.in[4] + sr * 8 + 4 * lane); *(f32x4*)(LOGF + er * 8 + 4 * lane) = v; } }
    }
    { float* s2 = (float*)(ws + W_SS2); float* s3 = (float*)(ws + W_SS3); float* sq = (float*)(ws + W_SSQ); for (int i = gtid; i < MT; i += NT) { s2[i] = 0.f; s3[i] = 0.f; sq[i] = 0.f; }
        float* rp = (float*)(ws + W_ROPE);
        for (int i = gtid; i < LSEQ * 16; i += NT) { const int pos = i >> 4, k = i & 15; const float inv = exp2f(-(float)k * (13.287712379549449f / 16.f)); const float ang = (float)pos * inv;
            const double rev = (double)ang * 0.15915494309189535; const double fr = rev - __builtin_rint(rev); const float f = (float)fr;
            rp[2 * i] = __builtin_amdgcn_cosf(f); rp[2 * i + 1] = __builtin_amdgcn_sinf(f); } }
}
__device__ __forceinline__ void p3_scan(const KArgs& a, int gw, int NGW, int lane) {
    const float* LOGF = (const float*)(a.ws + W_LOGF); float* FB = (float*)(a.ws + W_FB);
    for (int s = gw; s < NB * NH + SB * NH; s += NGW) { int base, nch, h;
        if (s < NB * NH) { base = (s >> 3) * LP; nch = LP / 64; h = s & 7; } else { const int t = s - NB * NH; base = MP + (t >> 3) * SXR; nch = SXR / 64; h = t & 7; }
        float carry = 0.f;
        for (int c = 0; c < nch; ++c) { float v = LOGF[(size_t)(base + 64 * c + lane) * 8 + h];
#pragma unroll
            for (int o = 1; o < 64; o <<= 1) { const float t = __shfl_up(v, o); if (lane >= o) v += t; }
            v += carry; FB[(size_t)h * ER + base + 64 * c + lane] = -v * LOG2E; carry = __shfl(v, 63); } }
}
__device__ __forceinline__ void p9_final(const KArgs& a, int gw, int NGW, int lane, int G, int which) {
    const bf16* H = (const bf16*)(a.ws + W_H1B); const float* SS = (const float*)(a.ws + W_SS3); const float* g = a.in[24]; f32x4 gv[4];
#pragma unroll
    for (int j = 0; j < 4; ++j) gv[j] = *(const f32x4*)(g + 4 * lane + 256 * j);
    pg8::StaticOrder S; S.init(MT, D, G, 0); const int lim = (S.nwg / G) * G, ntail = S.nwg - lim;
    int tpm = -1; if (lane < ntail) { pg8::Unit u; S.map(lim + lane, u); tpm = u.pm; }
    for (int m = 4 * gw; m < MT; m += 4 * NGW) { float* o;
        { const bool tl = __ballot(tpm == (m >> 8)) != 0ull; if (tl != (which == 1)) continue; }
        if (m >= MP) o = a.out + O_YS + (size_t)(m - MP) * D; else { const int b = m / LP, tp = m - b * LP; if (tp < 64) continue; o = a.out + O_YP + ((size_t)b * SEQ + (tp - 64)) * D; }
        u32x2 w[4][4]; float rs[4];
#pragma unroll
        for (int q = 0; q < 4; ++q) { rs[q] = __builtin_amdgcn_rsqf(SS[m + q] * (1.f / D) + EPS);
#pragma unroll
            for (int j = 0; j < 4; ++j) w[q][j] = *(const u32x2*)(H + (size_t)(m + q) * D + 4 * lane + 256 * j); }
#pragma unroll
        for (int q = 0; q < 4; ++q)
#pragma unroll
            for (int j = 0; j < 4; ++j) *(f32x4*)(o + (size_t)q * D + 4 * lane + 256 * j) = (f32x4){bflo(w[q][j].x), bfhi(w[q][j].x), bflo(w[q][j].y), bfhi(w[q][j].y)} * rs[q] * gv[j]; }
}

struct AttnP { const bf16* Q; const bf16* K1; const bf16* K2; const bf16* V; const float* FB; bf16* O; float* okp; float* ovp; int qpitch, k1pitch, vpitch, opitch, ntiles, q0, nq, cmode, kvlo, qlo, kvhi; float sl2; };
typedef short v4i16_t __attribute__((ext_vector_type(4)));
#define MFMA32(a, b, c) __builtin_amdgcn_mfma_f32_32x32x16_bf16((a), (b), (c), 0, 0, 0)
template <int DK, bool FOX, int BOFF> __device__ __forceinline__ void attn_qk(LAS unsigned char* kl  , const bf16x8 (&qf)[DK / 16], f32x16& p0, f32x16& p1, int lane) {
    constexpr int KP = DK == 64 ? 144 : 208, ND = DK / 16, NF = ND + (FOX ? 1 : 0);
    const int h = lane >> 5;
    bf16x8 ka[NF], kc[NF];
#pragma unroll
    for (int d0 = 0; d0 < ND; ++d0) { ka[d0] = *(const LAS bf16x8*)(kl + BOFF + 32 * d0); kc[d0] = *(const LAS bf16x8*)(kl + BOFF + 32 * KP + 32 * d0); }
    if (FOX) { LAS unsigned char* ka_ = kl - 16 * h + 128; ka[NF - 1] = *(const LAS bf16x8*)(ka_ + BOFF); kc[NF - 1] = *(const LAS bf16x8*)(ka_ + BOFF + 32 * KP); }
    __builtin_amdgcn_sched_barrier(0);
#pragma unroll
    for (int d0 = 0; d0 < ND; ++d0) {
        if (d0 == 0) { f32x16 z;
#pragma unroll
            for (int i = 0; i < 16; ++i) z[i] = 0.f;
            p0 = MFMA32(ka[0], qf[0], z); p1 = MFMA32(kc[0], qf[0], z); } else { p0 = MFMA32(ka[d0], qf[d0], p0); p1 = MFMA32(kc[d0], qf[d0], p1); } }
    if (FOX) { const short one = h == 0 ? (short)0x3F80 : (short)0; const bf16x8 qa = {one, one, one, 0, 0, 0, 0, 0};
        p0 = MFMA32(ka[NF - 1], qa, p0); p1 = MFMA32(kc[NF - 1], qa, p1); }
}
template <int BOFF> __device__ __forceinline__ void attn_sm_pv(LAS unsigned char* vl  , f32x16& p0, f32x16& p1, f32x16& o0, f32x16& o1, float& m_ref, float& l_run,
                                           bool first, int kvbase, bool needmask, int lo_l, int hi_l, int lane) {
    constexpr int VP = 144;
    const int h = lane >> 5;
    s16x4 vlo[8], vhi[8];
    {
#pragma unroll
        for (int k = 0; k < 4; ++k)
#pragma unroll
            for (int db = 0; db < 2; ++db) {
                vlo[2 * k + db] = __builtin_bit_cast(s16x4, __builtin_amdgcn_ds_read_tr16_b64_v4i16((LAS v4i16_t*)(vl + BOFF + (16 * k) * VP + 64 * db)));
                vhi[2 * k + db] = __builtin_bit_cast(s16x4, __builtin_amdgcn_ds_read_tr16_b64_v4i16((LAS v4i16_t*)(vl + BOFF + (16 * k + 8) * VP + 64 * db))); } }
    __builtin_amdgcn_sched_barrier(0);
    if (needmask) {
#pragma unroll
        for (int i = 0; i < 16; ++i) { const int kv = kvbase + (i & 3) + 8 * (i >> 2) + 4 * h;
            if (kv < lo_l || kv > hi_l) p0[i] = -INFINITY;
            if (kv + 32 < lo_l || kv + 32 > hi_l) p1[i] = -INFINITY; } }
    float ma = fmaxf(fmaxf(p0[0], p0[1]), p1[0]), mb = fmaxf(fmaxf(p0[2], p0[3]), p1[1]);
    ma = fmaxf(fmaxf(ma, p1[2]), p1[3]);
#pragma unroll
    for (int i = 4; i < 16; i += 4) { ma = fmaxf(fmaxf(ma, p0[i]), p0[i + 1]); mb = fmaxf(fmaxf(mb, p0[i + 2]), p0[i + 3]); ma = fmaxf(fmaxf(ma, p1[i]), p1[i + 1]); mb = fmaxf(fmaxf(mb, p1[i + 2]), p1[i + 3]); }
    float mx = fmaxf(ma, mb);
    { const auto rr = __builtin_amdgcn_permlane32_swap(__float_as_uint(mx), __float_as_uint(mx), false, false); mx = fmaxf(__uint_as_float(rr[0]), __uint_as_float(rr[1])); }
    const bool need = first || (mx - m_ref) > 8.f;
    if (__any(need)) { float dl = first ? mx : fmaxf(mx - m_ref, 0.f); if (!need || dl == -INFINITY) dl = 0.f;
        m_ref += dl; const float alpha = __builtin_amdgcn_exp2f(-dl); l_run *= alpha;
#pragma unroll
        for (int i = 0; i < 16; ++i) { o0[i] *= alpha; o1[i] *= alpha; } }
    float ps = 0.f, pt = 0.f;
#pragma unroll
    for (int i = 0; i < 16; ++i) { p0[i] = __builtin_amdgcn_exp2f(p0[i] - m_ref); p1[i] = __builtin_amdgcn_exp2f(p1[i] - m_ref); ps += p0[i]; pt += p1[i]; }
    l_run += ps + pt;
    bf16x8 pf[4];
#pragma unroll
    for (int s2 = 0; s2 < 2; ++s2) {
        u32x4 w0 = {pk2(p0[8 * s2], p0[8 * s2 + 1]), pk2(p0[8 * s2 + 2], p0[8 * s2 + 3]), pk2(p0[8 * s2 + 4], p0[8 * s2 + 5]), pk2(p0[8 * s2 + 6], p0[8 * s2 + 7])};
        u32x4 w1 = {pk2(p1[8 * s2], p1[8 * s2 + 1]), pk2(p1[8 * s2 + 2], p1[8 * s2 + 3]), pk2(p1[8 * s2 + 4], p1[8 * s2 + 5]), pk2(p1[8 * s2 + 6], p1[8 * s2 + 7])};
        pf[s2] = __builtin_bit_cast(bf16x8, w0); pf[2 + s2] = __builtin_bit_cast(bf16x8, w1); }
#pragma unroll
    for (int k = 0; k < 4; ++k) {
        const bf16x8 v0 = __builtin_shufflevector(vlo[2 * k], vhi[2 * k], 0, 1, 2, 3, 4, 5, 6, 7), v1 = __builtin_shufflevector(vlo[2 * k + 1], vhi[2 * k + 1], 0, 1, 2, 3, 4, 5, 6, 7);
        o0 = MFMA32(v0, pf[k], o0); o1 = MFMA32(v1, pf[k], o1); }
}
#ifndef SGV
#define SGV 8
#endif
template <int DK, bool FOX, int KOFF, int VOFF> __device__ __forceinline__ void attn_fused(LAS unsigned char* kl, LAS unsigned char* vl, const bf16x8 (&qf)[DK / 16], f32x16& p0, f32x16& p1, f32x16& pn0, f32x16& pn1,
                                                                                        f32x16& o0, f32x16& o1, float& m_ref, float& l_run, bool first, int kvbase, bool needmask, int lo_l, int hi_l, int lane) {
    constexpr int KP = DK == 64 ? 144 : 208, VP = 144, ND = DK / 16, NF = ND + (FOX ? 1 : 0);
    const int h = lane >> 5;
    bf16x8 ka[NF], kc[NF];
#pragma unroll
    for (int d0 = 0; d0 < ND; ++d0) { ka[d0] = *(const LAS bf16x8*)(kl + KOFF + 32 * d0); kc[d0] = *(const LAS bf16x8*)(kl + KOFF + 32 * KP + 32 * d0); }
    if (FOX) { LAS unsigned char* ka_ = kl - 16 * h + 128; ka[NF - 1] = *(const LAS bf16x8*)(ka_ + KOFF); kc[NF - 1] = *(const LAS bf16x8*)(ka_ + KOFF + 32 * KP); }
    if (needmask) {
#pragma unroll
        for (int i = 0; i < 16; ++i) { const int kv = kvbase + (i & 3) + 8 * (i >> 2) + 4 * h;
            if (kv < lo_l || kv > hi_l) p0[i] = -INFINITY;
            if (kv + 32 < lo_l || kv + 32 > hi_l) p1[i] = -INFINITY; } }
    float ma = fmaxf(fmaxf(p0[0], p0[1]), p1[0]), mb = fmaxf(fmaxf(p0[2], p0[3]), p1[1]);
    ma = fmaxf(fmaxf(ma, p1[2]), p1[3]);
#pragma unroll
    for (int i = 4; i < 16; i += 4) { ma = fmaxf(fmaxf(ma, p0[i]), p0[i + 1]); mb = fmaxf(fmaxf(mb, p0[i + 2]), p0[i + 3]); ma = fmaxf(fmaxf(ma, p1[i]), p1[i + 1]); mb = fmaxf(fmaxf(mb, p1[i + 2]), p1[i + 3]); }
    float mx = fmaxf(ma, mb);
    { const auto rr = __builtin_amdgcn_permlane32_swap(__float_as_uint(mx), __float_as_uint(mx), false, false); mx = fmaxf(__uint_as_float(rr[0]), __uint_as_float(rr[1])); }
    const bool need = first || (mx - m_ref) > 8.f;
    float dl = first ? mx : fmaxf(mx - m_ref, 0.f); if (!need || dl == -INFINITY) dl = 0.f;
    m_ref += dl; const float alpha = __builtin_amdgcn_exp2f(-dl); l_run *= alpha;
    __builtin_amdgcn_sched_barrier(0);
    float ps = 0.f, pt = 0.f;
#pragma unroll
    for (int g = 0; g < NF; ++g) {
        if (g < ND) { if (g == 0) { f32x16 z;
#pragma unroll
                for (int i = 0; i < 16; ++i) z[i] = 0.f;
                pn0 = MFMA32(ka[0], qf[0], z); } else pn0 = MFMA32(ka[g < ND ? g : 0], qf[g < ND ? g : 0], pn0); }
        else { const short one = h == 0 ? (short)0x3F80 : (short)0; const bf16x8 qa = {one, one, one, 0, 0, 0, 0, 0}; pn0 = MFMA32(ka[NF - 1], qa, pn0); }
#pragma unroll
        for (int i = (16 * g) / NF; i < (16 * (g + 1)) / NF; ++i) { o0[i] *= alpha;
#ifdef PROBE_EXP
            { float d_ = __builtin_amdgcn_exp2f(p0[i] - m_ref + 1.f); asm volatile("" :: "v"(d_)); }
#endif
            p0[i] = __builtin_amdgcn_exp2f(p0[i] - m_ref); ps += p0[i]; }
        __builtin_amdgcn_sched_barrier(0);
        if (g < ND) { if (g == 0) { f32x16 z;
#pragma unroll
                for (int i = 0; i < 16; ++i) z[i] = 0.f;
                pn1 = MFMA32(kc[0], qf[0], z); } else pn1 = MFMA32(kc[g < ND ? g : 0], qf[g < ND ? g : 0], pn1); }
        else { const short one = h == 0 ? (short)0x3F80 : (short)0; const bf16x8 qa = {one, one, one, 0, 0, 0, 0, 0}; pn1 = MFMA32(kc[NF - 1], qa, pn1); }
#pragma unroll
        for (int i = (16 * g) / NF; i < (16 * (g + 1)) / NF; ++i) { o1[i] *= alpha;
#ifdef PROBE_EXP
            { float d_ = __builtin_amdgcn_exp2f(p1[i] - m_ref + 1.f); asm volatile("" :: "v"(d_)); }
#endif
            p1[i] = __builtin_amdgcn_exp2f(p1[i] - m_ref); pt += p1[i]; }
        __builtin_amdgcn_sched_barrier(0);
    }
    l_run += ps + pt;
    __builtin_amdgcn_sched_barrier(0);
    s16x4 vlo[8], vhi[8];
#pragma unroll
    for (int k = 0; k < 4; ++k)
#pragma unroll
        for (int db = 0; db < 2; ++db) {
            vlo[2 * k + db] = __builtin_bit_cast(s16x4, __builtin_amdgcn_ds_read_tr16_b64_v4i16((LAS v4i16_t*)(vl + VOFF + (16 * k) * VP + 64 * db)));
            vhi[2 * k + db] = __builtin_bit_cast(s16x4, __builtin_amdgcn_ds_read_tr16_b64_v4i16((LAS v4i16_t*)(vl + VOFF + (16 * k + 8) * VP + 64 * db))); }
    bf16x8 pf[4];
#pragma unroll
    for (int s2 = 0; s2 < 2; ++s2) {
        u32x4 w0 = {pk2(p0[8 * s2], p0[8 * s2 + 1]), pk2(p0[8 * s2 + 2], p0[8 * s2 + 3]), pk2(p0[8 * s2 + 4], p0[8 * s2 + 5]), pk2(p0[8 * s2 + 6], p0[8 * s2 + 7])};
        u32x4 w1 = {pk2(p1[8 * s2], p1[8 * s2 + 1]), pk2(p1[8 * s2 + 2], p1[8 * s2 + 3]), pk2(p1[8 * s2 + 4], p1[8 * s2 + 5]), pk2(p1[8 * s2 + 6], p1[8 * s2 + 7])};
        pf[s2] = __builtin_bit_cast(bf16x8, w0); pf[2 + s2] = __builtin_bit_cast(bf16x8, w1); }
#pragma unroll
    for (int k = 0; k < 4; ++k) {
        const bf16x8 v0 = __builtin_shufflevector(vlo[2 * k], vhi[2 * k], 0, 1, 2, 3, 4, 5, 6, 7), v1 = __builtin_shufflevector(vlo[2 * k + 1], vhi[2 * k + 1], 0, 1, 2, 3, 4, 5, 6, 7);
        o0 = MFMA32(v0, pf[k], o0); o1 = MFMA32(v1, pf[k], o1); }
}
template <int DK, bool FOX> __device__ __forceinline__ void attn_unit(LAS unsigned char* lds, const AttnP& P) {
    constexpr int KP = DK == 64 ? 144 : 208, VP = 144, KBYTES = 64 * KP, VBYTES = 64 * VP, ND = DK / 16;
    int tid_ = threadIdx.x; asm volatile("" : "+v"(tid_));
    const int tid = tid_, lane = tid & 63, wid = __builtin_amdgcn_readfirstlane(tid >> 6), r = lane & 31, h = lane >> 5;
    const int lrow = tid >> 3, lch = tid & 7;
    LAS unsigned char* KB = lds; LAS unsigned char* VB = lds + 2 * KBYTES;
    LAS unsigned char* kl = KB + r * KP + 16 * h; LAS unsigned char* vl = VB + (4 * h + ((lane & 15) >> 2)) * VP + 32 * ((lane >> 4) & 1) + 8 * (lane & 3);
    const int q_abs = P.q0 + 32 * wid + r;
    const int qlim = P.cmode == 1 ? q_abs : (P.cmode == 2 ? (q_abs | 63) : 0x7fffffff);
    const int hi_l = qlim < P.kvhi - 1 ? qlim : P.kvhi - 1, lo_l = q_abs >= P.qlo ? P.kvlo : 0;
    const int qa0 = P.q0 + 32 * wid, qa1 = qa0 + 31;
    const int ql0 = P.cmode == 1 ? qa0 : (P.cmode == 2 ? (qa0 | 63) : 0x7fffffff), ql1 = P.cmode == 1 ? qa1 : (P.cmode == 2 ? (qa1 | 63) : 0x7fffffff);
    const int mnh = ql0 < P.kvhi - 1 ? ql0 : P.kvhi - 1, mxh = ql1 < P.kvhi - 1 ? ql1 : P.kvhi - 1, mxl = qa1 >= P.qlo ? P.kvlo : 0;
    const bool active = 32 * wid < P.nq;
    const int last_tile = (mxh >> 6) < P.ntiles - 1 ? (mxh >> 6) : P.ntiles - 1;
    bf16x8 qf[ND];
#pragma unroll
    for (int d0 = 0; d0 < ND; ++d0) { if (active) qf[d0] = *(const bf16x8*)(P.Q + (size_t)(32 * wid + r) * P.qpitch + 16 * d0 + 8 * h); else qf[d0] = (bf16x8){0, 0, 0, 0, 0, 0, 0, 0}; }
    float m_ref = 0.f, l_run = 0.f; f32x16 o0, o1, p0, p1, pn0, pn1;
#pragma unroll
    for (int i = 0; i < 16; ++i) { o0[i] = 0.f; o1[i] = 0.f; p0[i] = 0.f; p1[i] = 0.f; pn0[i] = 0.f; pn1[i] = 0.f; }
    u32x4 ak1 = {0u, 0u, 0u, 0u}, ak2 = {0u, 0u, 0u, 0u}, av = {0u, 0u, 0u, 0u}; float afb = 0.f;
#define A_LOADK(S, jt) do { S##k1 = *(const u32x4*)(P.K1 + (size_t)((jt) * 64 + lrow) * P.k1pitch + lch * 8); \
        if (DK == 96) S##k2 = *(const u32x4*)(P.K2 + (size_t)((jt) * 64 + ((tid >> 2) & 63)) * 32 + (tid & 3) * 8); \
        if (FOX) S##fb = P.FB[(jt) * 64 + (tid & 63)]; } while (0)
#define A_LOADV(S, jt) do { S##v = *(const u32x4*)(P.V + (size_t)((jt) * 64 + lrow) * P.vpitch + lch * 8); } while (0)
#define A_OUT8(ptr, VV, jt) do { if (FOX && (ptr) != nullptr) { const int tp_ = (jt) * 64 + lrow; if (tp_ >= PADR) { float* o_ = (ptr) + (size_t)tp_ * 512 + lch * 8; const u32x4 q_ = (VV); \
            *(f32x4*)o_ = (f32x4){bflo(q_.x), bfhi(q_.x), bflo(q_.y), bfhi(q_.y)}; *(f32x4*)(o_ + 4) = (f32x4){bflo(q_.z), bfhi(q_.z), bflo(q_.w), bfhi(q_.w)}; } } } while (0)
#define A_STOREK(S, b) do { LAS unsigned char* kb_ = KB + (b) * KBYTES; *(LAS u32x4*)(kb_ + lrow * KP + lch * 16) = S##k1; \
        if (DK == 96 && tid < 256) *(LAS u32x4*)(kb_ + (tid >> 2) * KP + 128 + (tid & 3) * 16) = S##k2; \
        if (FOX && tid < 64) { const unsigned w0_ = pk2(S##fb, 0.f) & 0xffffu; const float e1_ = S##fb - __uint_as_float(w0_ << 16); const unsigned w1_ = pk2(e1_, 0.f) & 0xffffu; const float e2_ = e1_ - __uint_as_float(w1_ << 16); \
            *(LAS u32x4*)(kb_ + tid * KP + 128) = (u32x4){w0_ | (w1_ << 16), pk2(e2_, 0.f) & 0xffffu, 0u, 0u}; } } while (0)
#define A_STOREV(S, b) do { *(LAS u32x4*)(VB + (b) * VBYTES + lrow * VP + lch * 16) = S##v; } while (0)
#define A_ITER(jt, L, S, PAR) do { const int jt_ = (jt); \
        { const int lk_ = jt_ + 2 < P.ntiles ? jt_ + 2 : P.ntiles - 1, lv_ = jt_ + 1 < P.ntiles ? jt_ + 1 : P.ntiles - 1; A_LOADK(a, lk_); A_LOADV(a, lv_); } \
        const bool mv_ = jt_ + 1 < P.ntiles; \
        const bool do_next = active && mv_ && jt_ + 1 <= last_tile, do_cur = active && jt_ <= last_tile; \
        const int kvbase = jt_ * 64; const bool needmask = (kvbase < mxl) || (kvbase + 63 > mnh); \
        if (active && jt_ <= last_tile) attn_fused<DK, FOX, (1 - PAR) * KBYTES, PAR * VBYTES>(kl, vl, qf, p0, p1, pn0, pn1, o0, o1, m_ref, l_run, jt_ == 0, kvbase, needmask, lo_l, hi_l, lane); \
        if (jt_ + 2 < P.ntiles) { A_STOREK(a, PAR); A_OUT8(P.okp, ak1, jt_ + 2); } \
        if (mv_) { A_STOREV(a, 1 - PAR); A_OUT8(P.ovp, av, jt_ + 1); } \
        asm volatile("s_waitcnt lgkmcnt(0)" ::: "memory"); __builtin_amdgcn_s_barrier(); asm volatile("" ::: "memory");     \
        p0 = pn0; p1 = pn1; } while (0)
    A_LOADK(a, 0); A_LOADV(a, 0); A_STOREK(a, 0); A_STOREV(a, 0); A_OUT8(P.okp, ak1, 0); A_OUT8(P.ovp, av, 0);
    if (P.ntiles > 1) { A_LOADK(a, 1); A_STOREK(a, 1); A_OUT8(P.okp, ak1, 1); }
    __syncthreads();
    if (active) attn_qk<DK, FOX, 0>(kl, qf, p0, p1, lane);
    __syncthreads();
    for (int jt = 0; jt < P.ntiles; jt += 2) {
        A_ITER(jt, a, b, 0);
        if (jt + 1 < P.ntiles) A_ITER(jt + 1, b, a, 1);
    }
#undef A_ITER
#undef A_LOADK
#undef A_LOADV
#undef A_STOREK
#undef A_STOREV
#undef A_OUT8
    float l; { const auto rr = __builtin_amdgcn_permlane32_swap(__float_as_uint(l_run), __float_as_uint(l_run), false, false); l = __uint_as_float(rr[0]) + __uint_as_float(rr[1]); }
    const float rl = 1.f / l;
    if (active && 32 * wid + r < P.nq) { bf16* op = P.O + (size_t)(32 * wid + r) * P.opitch + 4 * h;
#pragma unroll
        for (int g = 0; g < 4; ++g) {
            *(u32x2*)(op + 8 * g) = (u32x2){pk2(o0[4 * g] * rl, o0[4 * g + 1] * rl), pk2(o0[4 * g + 2] * rl, o0[4 * g + 3] * rl)};
            *(u32x2*)(op + 32 + 8 * g) = (u32x2){pk2(o1[4 * g] * rl, o1[4 * g + 1] * rl), pk2(o1[4 * g + 2] * rl, o1[4 * g + 3] * rl)}; } }
}
__device__ __forceinline__ void p4_attention(const KArgs& a, LAS unsigned char* lds, int vcu, int G) {
    unsigned char* ws = a.ws; const bf16* FQ = (const bf16*)(ws + W_FQ); bf16* OF = (bf16*)(ws + W_OCAT); const bf16* FK = (const bf16*)(ws + W_FK); const bf16* FV = (const bf16*)(ws + W_FV); const float* FB = (const float*)(ws + W_FB);
    const bf16* QM = (const bf16*)(ws + W_QMLA); const bf16* KV = (const bf16*)a.out; const bf16* KR = (const bf16*)(ws + W_KR); bf16* OM = (bf16*)(ws + W_OCAT) + 512;
    const float slf = 0.125f * LOG2E, slm = 0.10206207261596575f * LOG2E;
    for (int c = vcu; c < 256; c += G) { const int b = c >> 3, h = c & 7; const size_t r0 = (size_t)b * LP;
        for (int blk = 8; blk >= 0; --blk) { const int q0 = blk == 0 ? 0 : 64 + 256 * (blk - 1), nq = blk == 0 ? 64 : 256, nt = 4 * blk + 1;
            { AttnP P; P.Q = FQ + (r0 + q0) * 512 + h * 64; P.K1 = FK + r0 * 512 + h * 64; P.K2 = nullptr; P.V = FV + r0 * 512 + h * 64; P.FB = FB + (size_t)h * ER + r0; P.O = OF + (r0 + q0) * 1024 + h * 64; P.okp = blk == 8 ? a.out + O_KP + ((long)b * LSEQ - PADR) * 512 + h * 64 : nullptr; P.ovp = blk == 8 ? a.out + O_VP + ((long)b * LSEQ - PADR) * 512 + h * 64 : nullptr;
                P.qpitch = 512; P.k1pitch = 512; P.vpitch = 512; P.opitch = 1024; P.ntiles = nt; P.q0 = q0; P.nq = nq; P.cmode = 1; P.kvlo = PADR; P.qlo = PADR; P.kvhi = LP; P.sl2 = slf;
                attn_unit<64, true>(lds, P); }
            { AttnP P; P.Q = QM + (r0 + q0) * 768 + h * 96; P.K1 = KV + r0 * 1024 + h * 128; P.K2 = KR + r0 * 32; P.V = KV + r0 * 1024 + h * 128 + 64; P.FB = nullptr; P.okp = nullptr; P.ovp = nullptr; P.O = OM + (r0 + q0) * 1024 + h * 64;
                P.qpitch = 768; P.k1pitch = 1024; P.vpitch = 1024; P.opitch = 1024; P.ntiles = nt; P.q0 = q0; P.nq = nq; P.cmode = 2; P.kvlo = PADR; P.qlo = PADR; P.kvhi = LP; P.sl2 = slm;
                attn_unit<96, false>(lds, P); } }
        { const int typ = c >> 7, sb = (c & 127) >> 3; const size_t e0 = (size_t)MP + (size_t)sb * SXR, t0 = (size_t)MP + (size_t)sb * SN;
            if (typ == 0) { AttnP P; P.Q = FQ + t0 * 512 + h * 64; P.K1 = FK + e0 * 512 + h * 64; P.K2 = nullptr; P.V = FV + e0 * 512 + h * 64; P.FB = FB + (size_t)h * ER + e0; P.okp = nullptr; P.ovp = nullptr; P.O = OF + t0 * 1024 + h * 64;
                P.qpitch = 512; P.k1pitch = 512; P.vpitch = 512; P.opitch = 1024; P.ntiles = 17; P.q0 = PAST; P.nq = SN; P.cmode = 1; P.kvlo = 0; P.qlo = 0; P.kvhi = PAST + SN; P.sl2 = slf;
                attn_unit<64, true>(lds, P); }
            else { AttnP P; P.Q = QM + t0 * 768 + h * 96; P.K1 = KV + e0 * 1024 + h * 128; P.K2 = KR + e0 * 32; P.V = KV + e0 * 1024 + h * 128 + 64; P.FB = nullptr; P.okp = nullptr; P.ovp = nullptr; P.O = OM + t0 * 1024 + h * 64;
                P.qpitch = 768; P.k1pitch = 1024; P.vpitch = 1024; P.opitch = 1024; P.ntiles = 17; P.q0 = PAST; P.nq = SN; P.cmode = 0; P.kvlo = 0; P.qlo = 0; P.kvhi = PAST + SN; P.sl2 = slm;
                attn_unit<96, false>(lds, P); } }
    }
}

__device__ __forceinline__ void stagger(int bx, int step_ticks) {
    const unsigned long long t0 = __builtin_amdgcn_s_memrealtime(); const unsigned long long w = (unsigned long long)(((bx >> 3) & 7) * step_ticks);
    while (__builtin_amdgcn_s_memrealtime() - t0 < w) __builtin_amdgcn_s_sleep(16);
}
#ifndef STAG
#define STAG 0
#endif
#ifndef REP_P1
#define REP_P1 1
#endif
#ifndef REP_P4
#define REP_P4 1
#endif
#ifndef REP_P7
#define REP_P7 1
#endif
#define XB_TMO      128
#define XB_XCNT(j)  (256  + 64 * (j))
#define XB_XSUB(j)  (1280 + 64 * (j))
#define XB_XGEN(j)  (2304 + 64 * (j))
#define XB_TOP      3328
#define XB_TOPGEN   3392
#define XCD_BAR_WORDS 3456
#define XB_SPIN_CAP (1u << 18)

__device__ __forceinline__ unsigned xb_ld(unsigned* p)              { return __hip_atomic_load(p, __ATOMIC_RELAXED, __HIP_MEMORY_SCOPE_AGENT); }
__device__ __forceinline__ unsigned xb_add(unsigned* p, unsigned v) { return __hip_atomic_fetch_add(p, v, __ATOMIC_RELAXED, __HIP_MEMORY_SCOPE_AGENT); }
__device__ __forceinline__ unsigned xb_xcc_id() { return (unsigned)__builtin_amdgcn_s_getreg((3 << 11) | 20) & 0xFu; }
#define XB_SPIN(cond, bar) do { unsigned _sp = 0; while (cond) { __builtin_amdgcn_s_sleep(1); \
    if ((++_sp & 255u) == 0u) { if (xb_ld(&(bar)[XB_TMO])) break; if (_sp > XB_SPIN_CAP) { atomicAdd(&(bar)[XB_TMO], 1u); break; } } } } while (0)

struct XcdBarrier {
    unsigned* bar; unsigned x;
    volatile LAS unsigned* st;
};

__device__ __forceinline__ XcdBarrier xcd_barrier_post(unsigned* bar, volatile LAS unsigned* st) {
    XcdBarrier b; b.bar = bar; b.x = xb_xcc_id(); b.st = st;
    if (threadIdx.x == 0) (void)xb_add(&bar[XB_XCNT(b.x)], 1u);
    return b;
}
__device__ __forceinline__ void xcd_barrier_complete(unsigned* bar, unsigned x, unsigned& nloc, unsigned& nx) {
    const unsigned G = gridDim.x * gridDim.y * gridDim.z;
    unsigned sum, cnt, mine, sp = 0u;
    for (;;) {
        sum = 0u; cnt = 0u; mine = 0u;
#pragma unroll
        for (unsigned j = 0; j < 16; ++j) { const unsigned c = xb_ld(&bar[XB_XCNT(j)]); sum += c; cnt += (c > 0u) ? 1u : 0u; mine = (j == x) ? c : mine; }
        if (sum == G) break;
        __builtin_amdgcn_s_sleep(1);
        if ((++sp & 255u) == 0u) { if (xb_ld(&bar[XB_TMO])) break; if (sp > XB_SPIN_CAP) { atomicAdd(&bar[XB_TMO], 1u); break; } }
    }
    nloc = mine > 0u ? mine : 1u; nx = cnt > 0u ? cnt : 1u;
}

__device__ __forceinline__ void xcd_barrier(const XcdBarrier& b) {
    asm volatile("s_waitcnt vmcnt(0)" ::: "memory");
    __syncthreads();
    if (threadIdx.x == 0) {
        unsigned* bar = b.bar;
        __builtin_amdgcn_s_waitcnt(0);
        unsigned nloc = b.st[0], nx = b.st[1];
        if (nloc == 0u) { xcd_barrier_complete(bar, b.x, nloc, nx); b.st[0] = nloc; b.st[1] = nx; }
        const unsigned old = xb_add(&bar[XB_XSUB(b.x)], 1u);
        const unsigned gen = old / nloc;
        if (old + 1u == (gen + 1u) * nloc) {
            __builtin_amdgcn_fence(__ATOMIC_RELEASE, "agent");
            asm volatile("s_waitcnt vmcnt(0)" ::: "memory");
            const unsigned og = xb_add(&bar[XB_TOP], 1u);
            const unsigned tg = og / nx;
            if (og + 1u == (tg + 1u) * nx) xb_add(&bar[XB_TOPGEN], 1u);
            else XB_SPIN(xb_ld(&bar[XB_TOPGEN]) == tg, bar);
            __builtin_amdgcn_fence(__ATOMIC_ACQUIRE, "agent");
            xb_add(&bar[XB_XGEN(b.x)], 1u);
            asm volatile("s_waitcnt vmcnt(0)" ::: "memory");
        } else {
            XB_SPIN(xb_ld(&bar[XB_XGEN(b.x)]) == gen, bar);
            __builtin_amdgcn_fence(__ATOMIC_ACQUIRE, "agent");
            asm volatile("s_waitcnt vmcnt(0)" ::: "memory");
        }
    }
    __syncthreads();
}

constexpr int LDS_BYTES = 147456;
typedef const __attribute__((address_space(4))) KArgs* kargs_cptr;
#if defined(__HIP_DEVICE_COMPILE__)
__device__ __forceinline__ KArgs load_args() { auto p = __builtin_amdgcn_kernarg_segment_ptr(); asm volatile("" : "+s"(p)); const kargs_cptr q = (kargs_cptr)p; KArgs r;
#pragma unroll
    for (int i = 0; i < 25; ++i) r.in[i] = q->in[i];
    r.out = q->out; r.ws = q->ws; return r; }
#else
__device__ __forceinline__ KArgs load_args() { return KArgs{}; }
#endif
#define LANEVARS int t_ = threadIdx.x; asm volatile("" : "+v"(t_)); const int lane = t_ & 63, wave = __builtin_amdgcn_readfirstlane(t_ >> 6), gw = vcu * 8 + wave, gtid = bx * 512 + t_; (void)gtid; (void)lane; (void)gw
#define PHASE_BEGIN const KArgs a = load_args(); unsigned char* ws = a.ws; (void)ws; const int G = gridDim.x, bx = blockIdx.x, vcu = (G % 8 == 0) ? (bx % 8) * (G / 8) + bx / 8 : bx, NGW = G * 8, NT = G * 512; (void)NGW; (void)NT; (void)vcu; const pg8::AMap nat{0, 0, 256}; (void)nat
#define SEAM() do { __syncthreads(); grid.sync(); } while (0)
#define SEAMX() xcd_barrier(xbar)
__global__ void __launch_bounds__(512, 2) mega_fwd(KArgs a_in) {
    extern __shared__ __attribute__((aligned(16))) unsigned char lds_raw[];
    cg::grid_group grid = cg::this_grid();
    LAS unsigned char* lds = (LAS unsigned char*)lds_raw;
    (void)a_in;
    volatile LAS unsigned* xst = (volatile LAS unsigned*)(lds + 131072 + 1024);
    if (threadIdx.x < 2) xst[threadIdx.x] = 0u;
    __syncthreads();
    const XcdBarrier xbar = xcd_barrier_post((unsigned*)(load_args().ws + W_BAR), xst);
    { PHASE_BEGIN; LANEVARS; p0_prologue(a, lds, gw, NGW, wave, lane, gtid, NT); }
    SEAM();
    for (int rep_ = 0; rep_ < REP_P1; ++rep_) { PHASE_BEGIN;
        pg8::Gemm g{(const bf16*)(ws + W_XN), (const bf16*)(ws + W_WIN), MT, INWP, D}; pg8::StaticOrder S; S.init(MT, INWP, G, bx);
        pg8::EpiWin E{(bf16*)(ws + W_FQ), (bf16*)(ws + W_FK), (bf16*)(ws + W_FV), (bf16*)(ws + W_GATES), a.out, (bf16*)(ws + W_CQ), (float*)(ws + W_SSQ), (bf16*)(ws + W_CKVN), (bf16*)(ws + W_KR), (float*)(ws + W_LOGF), (const float*)(ws + W_ROPE), a.in[14], a.in[11], (LAS float*)(lds + 131072 + 4096)};
        pg8::gemm_phase<pg8::EpiWin, pg8::StaticOrder, true, true>(lds, g, S, E, nat); }
    SEAMX();
    { PHASE_BEGIN; LANEVARS; p3_scan(a, gw, NGW, lane); }
    { PHASE_BEGIN; pg8::Gemm g{(const bf16*)(ws + W_CQ), (const bf16*)(ws + W_WUQ), MT, 768, 384}; pg8::StaticOrder S; S.init(MT, 768, G, bx);
        pg8::EpiQ E{(bf16*)(ws + W_QMLA), (const float*)(ws + W_ROPE), (const float*)(ws + W_SSQ)};
        pg8::gemm_phase<pg8::EpiQ, pg8::StaticOrder, true, true>(lds, g, S, E, nat); }
    { PHASE_BEGIN; pg8::Gemm g{(const bf16*)(ws + W_CKVN), (const bf16*)(ws + W_WUKV), ER, 1024, 256}; pg8::StaticOrder S; S.init(ER, 1024, G, bx);
        pg8::EpiPlain E{(bf16*)a.out, 1024};
        pg8::gemm_phase<pg8::EpiPlain, pg8::StaticOrder, true, true>(lds, g, S, E, nat); }
    SEAMX();
    { PHASE_BEGIN; p4_attention(a, lds, vcu, G); }
#if REP_P4 > 1
    SEAMX();
    { PHASE_BEGIN; p4_attention(a, lds, vcu, G); }
#endif
    SEAMX();
    { PHASE_BEGIN; pg8::Gemm g{(const bf16*)(ws + W_OCAT), (const bf16*)(ws + W_WOC), MT, D, 1024}; pg8::StaticOrder S; S.init(MT, D, G, bx);
        pg8::EpiMixCat E{(bf16*)(ws + W_MIX), (const bf16*)(ws + W_GATES)};
        pg8::gemm_phase<pg8::EpiMixCat, pg8::StaticOrder, true, true>(lds, g, S, E, nat); }
    SEAMX();
    { PHASE_BEGIN; pg8::Gemm g{(const bf16*)(ws + W_MIX), (const bf16*)(ws + W_WOUT), MT, D, D}; pg8::StaticOrder S; S.init(MT, D, G, bx);
        pg8::EpiH1 E{a.in[0], a.in[8], a.in[1], (float*)(ws + W_H1), (bf16*)(ws + W_H1B), (float*)(ws + W_SS2)};
        pg8::gemm_phase<pg8::EpiH1, pg8::StaticOrder, true, true>(lds, g, S, E, nat); }
    SEAMX();
    for (int rep_ = 0; rep_ < REP_P7; ++rep_) {
    { PHASE_BEGIN; pg8::Gemm g{(const bf16*)(ws + W_H1B), (const bf16*)(ws + W_WUP), 269 * 256, UPW, D}; pg8::StaticOrder S; S.init(269 * 256, UPW, G, bx);
        pg8::EpiConv<false> E{(bf16*)(ws + W_G), (const float*)(ws + W_SS2), a.in[21], a.in[22], a.in[7], a.out, 126};
        pg8::gemm_phase<pg8::EpiConv<false>, pg8::StaticOrder, true, true>(lds, g, S, E, pg8::AMap{1, 126, 252}); }
    { PHASE_BEGIN; pg8::Gemm g{(const bf16*)(ws + W_H1B) + (size_t)MP * D, (const bf16*)(ws + W_WUP), 256, UPW, D}; pg8::StaticOrder S; S.init(256, UPW, G, G - 1 - bx);
        pg8::EpiConv<true> E{(bf16*)(ws + W_G), (const float*)(ws + W_SS2), a.in[21], a.in[22], a.in[7], a.out, 128};
        pg8::gemm_phase<pg8::EpiConv<true>, pg8::StaticOrder, true, true>(lds, g, S, E, pg8::AMap{1, 128, 256}); }
    }
    SEAMX();
    { PHASE_BEGIN; pg8::Gemm g{(const bf16*)(ws + W_G), (const bf16*)(ws + W_WDN), MT, D, DFF}; pg8::StaticOrder S; S.init(MT, D, G, bx); S.lim = (S.nwg / G) * G;
        pg8::EpiH2 E{(bf16*)(ws + W_H1B), (float*)(ws + W_SS3)};
        pg8::gemm_phase<pg8::EpiH2, pg8::StaticOrder, true, true>(lds, g, S, E, nat); }
    SEAMX();
    { PHASE_BEGIN; pg8::Gemm g{(const bf16*)(ws + W_G), (const bf16*)(ws + W_WDN), MT, D, DFF}; pg8::StaticOrder S; S.init(MT, D, G, bx);
        const int lim = (S.nwg / G) * G, ntail = S.nwg - lim; S.c = lim + bx; S.G = 1 << 24;
        pg8::EpiH2 E{(bf16*)(ws + W_H1B), (float*)(ws + W_SS3)};
        pg8::gemm_phase<pg8::EpiH2, pg8::StaticOrder, true, true>(lds, g, S, E, nat);
        if (bx >= ntail) { LANEVARS; p9_final(a, (bx - ntail) * 8 + wave, (G - ntail) * 8, lane, G, 0); } }
    SEAMX();
    { PHASE_BEGIN; LANEVARS; p9_final(a, gw, NGW, lane, G, 1); }
}

extern "C" void kernel_launch(void* const* d_in, const int* in_sizes, int n_in, void* d_out, int out_size, void* d_ws, size_t ws_size, hipStream_t stream) {
    static int grid = 0;
    if (grid == 0) {
        if (n_in != 25 || (size_t)out_size != O_END || ws_size < W_END) { fprintf(stderr, "kernel_launch: unexpected sizes n_in %d out %d (want %zu) ws %zu (want %zu)\n", n_in, out_size, (size_t)O_END, ws_size, (size_t)W_END); grid = -1; return; }
        int dev = 0, cus = 0, per_cu = 0;
        hipGetDevice(&dev); hipDeviceGetAttribute(&cus, hipDeviceAttributeMultiprocessorCount, dev);
        hipFuncSetAttribute((const void*)mega_fwd, hipFuncAttributeMaxDynamicSharedMemorySize, LDS_BYTES);
        hipOccupancyMaxActiveBlocksPerMultiprocessor(&per_cu, (const void*)mega_fwd, 512, LDS_BYTES);
        (void)hipGetLastError();
        if (per_cu < 1) per_cu = 1;
        grid = cus;
        if (grid > 256) grid = 256;
    }
    if (grid < 0) return;
    if (hipMemsetAsync((char*)d_ws + W_BAR, 0, XCD_BAR_WORDS * 4, stream) != hipSuccess) { fprintf(stderr, "kernel_launch: hipMemsetAsync failed\n"); return; }
    KArgs a{};
    for (int i = 0; i < 25; ++i) a.in[i] = (const float*)d_in[i];
    a.out = (float*)d_out; a.ws = (unsigned char*)d_ws;
    void* args[] = {&a};
    hipError_t e = hipLaunchCooperativeKernel((const void*)mega_fwd, dim3(grid), dim3(512), args, LDS_BYTES, stream);
    if (e != hipSuccess) fprintf(stderr, "cooperative launch failed: %s (grid %d)\n", hipGetErrorString(e), grid);
}
```

```cpp
#include <hip/hip_runtime.h>
#include <hip/hip_cooperative_groups.h>
#include <cstdio>
#include <cstdint>
namespace cg = cooperative_groups;

constexpr int D = 1024, NB = 32, SEQ = 2048, NMETA = 16, LSEQ = 2064, PADR = 48, LP = 2112;
constexpr int MP = NB * LP;
constexpr int SB = 16, SN = 16, PAST = 1024, MS = SB * SN;
constexpr int MT = MP + MS;
constexpr int MTA = MT + 256;
constexpr int SXR = 1088;
constexpr int ER = MP + SB * SXR;
constexpr int NH = 8, INW = 4264, INWP = 4352, DFF = 2816, UPW = 5632;
constexpr int OFF_FF = 1536, OFF_CQ = 1544, OFF_CKV = 1928, OFF_KR = 2184, OFF_GATE = 2216;
constexpr float EPS = 1e-6f, LOG2E = 1.4426950408889634f;
constexpr size_t O_YP = 0, O_YS = O_YP + (size_t)NB * SEQ * D, O_KP = O_YS + (size_t)MS * D, O_VP = O_KP + (size_t)NB * LSEQ * 512, O_LFP = O_VP + (size_t)NB * LSEQ * 512,
                 O_CKVP = O_LFP + (size_t)NB * LSEQ * 8, O_KRP = O_CKVP + (size_t)NB * LSEQ * 256, O_CVP = O_KRP + (size_t)NB * LSEQ * 32, O_KS = O_CVP + (size_t)NB * 2 * UPW,
                 O_VS = O_KS + (size_t)MS * 512, O_LFS = O_VS + (size_t)MS * 512, O_CKVS = O_LFS + (size_t)MS * 8, O_KRS = O_CKVS + (size_t)MS * 256, O_CVS = O_KRS + (size_t)MS * 32,
                 O_END = O_CVS + (size_t)SB * 2 * UPW;
constexpr size_t AL(size_t x) { return (x + 4095) & ~(size_t)4095; }
constexpr size_t W_WIN = 0, W_WUQ = AL(W_WIN + (size_t)INWP * D * 2), W_WUKV = AL(W_WUQ + (size_t)768 * 384 * 2), W_WOC = AL(W_WUKV + (size_t)1024 * 256 * 2),
                 W_WOUT = AL(W_WOC + (size_t)1024 * 1024 * 2), W_WUP = AL(W_WOUT + (size_t)D * D * 2), W_WDN = AL(W_WUP + (size_t)UPW * D * 2), W_ROPE = AL(W_WDN + (size_t)D * DFF * 2),
                 W_SS2 = AL(W_ROPE + (size_t)LSEQ * 16 * 8), W_SS3 = AL(W_SS2 + (size_t)MT * 4), W_SSQ = AL(W_SS3 + (size_t)MT * 4), W_BAR = AL(W_SSQ + (size_t)MT * 4), W_XN = AL(W_BAR + 16384),
                 W_FQ = AL(W_XN + (size_t)MTA * D * 2), W_FK = AL(W_FQ + (size_t)MTA * 512 * 2), W_FV = AL(W_FK + (size_t)ER * 512 * 2), W_MISC = AL(W_FV + (size_t)ER * 512 * 2),
                 W_GATES = AL(W_MISC + (size_t)MT * 768 * 4), W_OCAT = AL(W_GATES + (size_t)MT * 2048 * 2), W_END = AL(W_OCAT + (size_t)MTA * 1024 * 2);
constexpr size_t W_CQ = W_OCAT  ;
constexpr size_t W_XN_END = W_XN;
static_assert(W_XN_END <= W_FQ, "XN-region overlay");
constexpr size_t W_MIX = W_XN;
constexpr size_t W_QMLA = W_MISC, W_CKVN = AL(W_QMLA + (size_t)MTA * 768 * 2), W_KR = AL(W_CKVN + (size_t)ER * 256 * 2), W_LOGF = AL(W_KR + (size_t)ER * 32 * 2), W_FB = AL(W_LOGF + (size_t)ER * 8 * 4);
static_assert(W_FB + (size_t)ER * 8 * 4 <= W_GATES, "MISC-region overlay");
constexpr size_t W_H1 = W_GATES, W_H1B = W_MISC, W_G = W_XN;
static_assert(W_G + (size_t)MT * DFF * 2 <= W_MISC, "G overlay");
static_assert((size_t)ER * 1024 * 2 <= (size_t)NB * SEQ * D * 4, "KVMLA lives in the y_prompt region of d_out until the last phase");

#define GAS __attribute__((address_space(1)))
#define LAS __attribute__((address_space(3)))
typedef unsigned short bf16;
typedef unsigned u32x4 __attribute__((ext_vector_type(4)));
typedef unsigned u32x2 __attribute__((ext_vector_type(2)));
typedef float f32x4 __attribute__((ext_vector_type(4)));
typedef float f32x2v __attribute__((ext_vector_type(2)));
typedef float f32x16 __attribute__((ext_vector_type(16)));
typedef short bf16x8 __attribute__((ext_vector_type(8)));
typedef short s16x4 __attribute__((ext_vector_type(4)));
typedef __bf16 bf16x2_t __attribute__((ext_vector_type(2)));
#define LDS_WAIT() asm volatile("s_waitcnt lgkmcnt(0)" ::: "memory")
__device__ __forceinline__ unsigned pk2(float lo, float hi) { f32x2v v = {lo, hi}; bf16x2_t b = __builtin_convertvector(v, bf16x2_t); return __builtin_bit_cast(unsigned, b); }
__device__ __forceinline__ float bflo(unsigned w) { return __uint_as_float(w << 16); }
__device__ __forceinline__ float bfhi(unsigned w) { return __uint_as_float(w & 0xffff0000u); }
__device__ __forceinline__ u32x4 pk8(f32x4 a, f32x4 b) { u32x4 w; w.x = pk2(a[0], a[1]); w.y = pk2(a[2], a[3]); w.z = pk2(b[0], b[1]); w.w = pk2(b[2], b[3]); return w; }
__device__ __forceinline__ float wave_sum(float v) {
#pragma unroll
    for (int o = 1; o < 64; o <<= 1) v += __shfl_xor(v, o);
    return v;
}
__device__ __forceinline__ int ext_row(int m) { return m < MP ? m : MP + ((m - MP) >> 4) * SXR + PAST + ((m - MP) & 15); }
__device__ __forceinline__ int out_row(int m) {
    if (m >= MP) return m < MT ? -1 - (m - MP) : (int)0x80000000;
    const int b = m / LP, tp = m - b * LP;
    return tp >= PADR ? b * LSEQ + (tp - PADR) : (int)0x80000000;
}
__device__ __forceinline__ int pos_of(int m) { if (m >= MP) return PAST + ((m - MP) & 15); const int tp = m % LP; return tp >= PADR ? tp - PADR : 0; }
struct KArgs { const float* in[25]; float* out; unsigned char* ws; };

namespace pg8 {
#define PG8_LAS __attribute__((address_space(3)))
typedef unsigned short bf16_t;
typedef short bf16x8 __attribute__((ext_vector_type(8)));
typedef float f32x4 __attribute__((ext_vector_type(4)));
typedef unsigned u32x4 __attribute__((ext_vector_type(4)));
constexpr int BM = 256, BK = 64, HALF = 128, HTB = HALF * BK * 2  , STAGE_BYTES = 8 * HTB, NXCD = 8, WGM = 8;

__host__ __device__ __forceinline__ int lds_byte(int r, int c) { const int st = (r >> 4) * 2 + (c >> 5), rr = r & 15, cc = c & 31, ob = rr * 64 + cc * 2; return st * 1024 + (ob ^ (((ob >> 9) & 1) << 5)); }
__host__ __device__ __forceinline__ void stage_rc(int b, int& R, int& C) { const int st = b / 1024, sb = b % 1024, swz = sb ^ (((sb >> 9) & 1) << 5); R = (st >> 1) * 16 + swz / 64; C = (st & 1) * 32 + (swz % 64) / 2; }
__host__ __device__ __forceinline__ int perm32(int rho) { const int n = rho >> 4, i = rho & 15; return 8 * (i >> 2) + 4 * n + (i & 3); }

struct Unit { int pm, pn; };
struct Gemm { const bf16_t* A; const bf16_t* Bt; int M, N, K; };

struct StaticOrder {
    int nM, nN, nwg, G, c, lim;
    __host__ __device__ void init(int M, int N, int G_, int c_) { nM = M / BM; nN = N / BM; nwg = nM * nN; G = G_; c = c_; lim = nwg; }
    __host__ __device__ void map(int L, Unit& u) const {
        int wgid = L; { const int q = nwg / NXCD, r = nwg % NXCD, xcd = wgid % NXCD, off = wgid / NXCD; wgid = (xcd < r ? xcd * (q + 1) : r * (q + 1) + (xcd - r) * q) + off; }
        const int nig = WGM * nN, gid = wgid / nig, fm = gid * WGM, gsz = (nM - fm) < WGM ? (nM - fm) : WGM;
        u.pm = fm + ((wgid % nig) % gsz); u.pn = (wgid % nig) / gsz;
    }
    __host__ __device__ bool next(int i, Unit& u) const { const long L = (long)i * G + c; if (L >= lim) return false; map((int)L, u); return true; }
    __device__ __forceinline__ void a_ready(const Unit&) const {}
    __device__ __forceinline__ void done(const Unit&) const {}
};


struct AMap { int perm, wrs, trows; };
#define PG8_ROW(ai, m) (u.pm * BM + (ai) * HALF + wr * 64 + (m) * 16 + fr)
#define PG8_EACH_AM _Pragma("unroll") for (int ai = 0; ai < 2; ++ai) _Pragma("unroll") for (int m = 0; m < 4; ++m)
#define PG8_RELANE do { int t_ = threadIdx.x; asm volatile("" : "+v"(t_)); fr = t_ & 15; fq = (t_ >> 4) & 3; const int w_ = __builtin_amdgcn_readfirstlane(t_ >> 6); wr = w_ >> 2; wc = w_ & 3; } while (0)
#define PG8_EACH_BJ _Pragma("unroll") for (int bj = 0; bj < 2; ++bj)
__device__ __forceinline__ f32x4 sig4(f32x4 x) { f32x4 r;
#pragma unroll
    for (int i = 0; i < 4; ++i) r[i] = __builtin_amdgcn_rcpf(1.f + __expf(-x[i])); return r; }
__device__ __forceinline__ f32x4 unlo(u32x2 w) { return (f32x4){::bflo(w.x), ::bfhi(w.x), ::bflo(w.y), ::bfhi(w.y)}; }
__device__ __forceinline__ float dpp_shr1(float v) { return __builtin_bit_cast(float, __builtin_amdgcn_update_dpp(0, __builtin_bit_cast(int, v), 0x111, 0xF, 0xF, false)); }

struct EpiPlain {
    static constexpr bool PERM = true, AFTER_DRAIN = false, MIDHOOK = false, PROBE2 = false;
    bf16_t* O; int ldc;
    __device__ __forceinline__ void operator()(const f32x4 (&acc)[2][2][4][2], const Unit& u, int wr, int wc, int fr, int fq) const { PG8_RELANE;
        const int colb = u.pn * BM + wc * 32 + 8 * fq;
        PG8_EACH_AM { bf16_t* p = O + (size_t)PG8_ROW(ai, m) * ldc + colb;
            PG8_EACH_BJ *(u32x4*)(p + bj * HALF) = ::pk8(acc[ai][bj][m][0], acc[ai][bj][m][1]); }
    }
};
struct EpiWin {
    static constexpr bool PERM = true, AFTER_DRAIN = false, MIDHOOK = false, PROBE2 = false;
    bf16_t *FQ, *FK, *FV, *GATES; float* out; bf16_t* CQ; float* SSQ; bf16_t *CKVN, *KR; float* LOGF; const float *rope, *gkv, *bforget; PG8_LAS float* xch;
    __device__ __forceinline__ void operator()(const f32x4 (&acc)[2][2][4][2], const Unit& u, int wr, int wc, int fr, int fq) const { PG8_RELANE;
        const int pn = u.pn, cw = wc * 32 + 8 * fq;
        if (pn == 8) {
            float ssr[8];
            PG8_EACH_AM { float ss = 0.f;
                PG8_EACH_BJ { const f32x4 a = acc[ai][bj][m][0], b = acc[ai][bj][m][1]; ss += (a[0] * a[0] + a[1] * a[1]) + (a[2] * a[2] + a[3] * a[3]) + (b[0] * b[0] + b[1] * b[1]) + (b[2] * b[2] + b[3] * b[3]); }
                ss += __shfl_xor(ss, 16); ss += __shfl_xor(ss, 32); ssr[ai * 4 + m] = ss;
                if (fq == 0) xch[(ai * HALF + wr * 64 + m * 16 + fr) * 4 + wc] = ss; }
            asm volatile("s_waitcnt lgkmcnt(0)" ::: "memory"); __builtin_amdgcn_s_barrier(); asm volatile("" ::: "memory");
            f32x4 gk[2][2];
            PG8_EACH_BJ { gk[bj][0] = *(const f32x4*)(gkv + bj * HALF + cw); gk[bj][1] = *(const f32x4*)(gkv + bj * HALF + cw + 4); }
            PG8_EACH_AM { const int row = PG8_ROW(ai, m); const PG8_LAS f32x4* xp = (const PG8_LAS f32x4*)(xch + (ai * HALF + wr * 64 + m * 16 + fr) * 4); const f32x4 s4 = *xp;
                const float rk = __builtin_amdgcn_rsqf(((s4[0] + s4[1]) + (s4[2] + s4[3])) * (1.f / 256.f) + EPS); const int er = ::ext_row(row), orow = ::out_row(row);
                float* o = nullptr; if (orow >= 0) o = out + O_CKVP + (size_t)orow * 256 + cw; else if (orow != (int)0x80000000) o = out + O_CKVS + (size_t)(-1 - orow) * 256 + cw;
                PG8_EACH_BJ { const f32x4 a = acc[ai][bj][m][0] * rk * gk[bj][0], b = acc[ai][bj][m][1] * rk * gk[bj][1];
                    *(u32x4*)(CKVN + (size_t)er * 256 + bj * HALF + cw) = ::pk8(a, b);
                    if (o) { *(f32x4*)(o + bj * HALF) = a; *(f32x4*)(o + bj * HALF + 4) = b; } }
                asm volatile("" ::: "memory"); }
            (void)ssr; return; }
        PG8_EACH_AM { const int row = PG8_ROW(ai, m);
            if (pn < 2) { bf16_t* p = FQ + (size_t)row * 512 + pn * 256 + cw;
                PG8_EACH_BJ *(u32x4*)(p + bj * HALF) = ::pk8(acc[ai][bj][m][0] * (0.125f * LOG2E), acc[ai][bj][m][1] * (0.125f * LOG2E)); }
            else if (pn < 6) { const int which = (pn - 2) >> 1, c = ((pn - 2) & 1) * 256 + cw; const int er = ::ext_row(row), orow = ::out_row(row);
                bf16_t* p = (which ? FV : FK) + (size_t)er * 512 + c; float* o = nullptr;
                if (orow < 0 && orow != (int)0x80000000) o = out + (which ? O_VS : O_KS) + (size_t)(-1 - orow) * 512 + c;
                PG8_EACH_BJ { *(u32x4*)(p + bj * HALF) = ::pk8(acc[ai][bj][m][0], acc[ai][bj][m][1]);
                    if (o) { *(f32x4*)(o + bj * HALF) = acc[ai][bj][m][0]; *(f32x4*)(o + bj * HALF + 4) = acc[ai][bj][m][1]; } } }
            else if (pn < 8) { float ss = 0.f;
                PG8_EACH_BJ { const f32x4 a = acc[ai][bj][m][0], b = acc[ai][bj][m][1];
                    if (pn == 6 || bj == 0) { *(u32x4*)(CQ + (size_t)row * 384 + (pn - 6) * 256 + bj * HALF + cw) = ::pk8(a, b);
                        ss += (a[0] * a[0] + a[1] * a[1]) + (a[2] * a[2] + a[3] * a[3]) + (b[0] * b[0] + b[1] * b[1]) + (b[2] * b[2] + b[3] * b[3]); }
                    else if (wc == 0) { const int er = ::ext_row(row), orow = ::out_row(row); const float* t = rope + ((size_t)::pos_of(row) * 16 + 8 * (fq & 1)) * 2; const float sg = (fq < 2) ? -1.f : 1.f;
                        const f32x4 t0 = *(const f32x4*)t, t1 = *(const f32x4*)(t + 4), t2 = *(const f32x4*)(t + 8), t3 = *(const f32x4*)(t + 12); f32x4 q0, q1, c0, c1;
#pragma unroll
                        for (int i = 0; i < 4; ++i) { q0[i] = __shfl_xor(a[i], 32); q1[i] = __shfl_xor(b[i], 32); }
                        c0[0] = a[0] * t0[0] + sg * q0[0] * t0[1]; c0[1] = a[1] * t0[2] + sg * q0[1] * t0[3]; c0[2] = a[2] * t1[0] + sg * q0[2] * t1[1]; c0[3] = a[3] * t1[2] + sg * q0[3] * t1[3];
                        c1[0] = b[0] * t2[0] + sg * q1[0] * t2[1]; c1[1] = b[1] * t2[2] + sg * q1[1] * t2[3]; c1[2] = b[2] * t3[0] + sg * q1[2] * t3[1]; c1[3] = b[3] * t3[2] + sg * q1[3] * t3[3];
                        *(u32x4*)(KR + (size_t)er * 32 + 8 * fq) = ::pk8(c0, c1);
                        float* o = nullptr; if (orow >= 0) o = out + O_KRP + (size_t)orow * 32 + 8 * fq; else if (orow != (int)0x80000000) o = out + O_KRS + (size_t)(-1 - orow) * 32 + 8 * fq;
                        if (o) { *(f32x4*)o = c0; *(f32x4*)(o + 4) = c1; } }
                    else if (wc == 1 && fq == 0) { const int er = ::ext_row(row), orow = ::out_row(row); f32x4 c0, c1; const f32x4 bf0 = *(const f32x4*)bforget, bf1 = *(const f32x4*)(bforget + 4);
#pragma unroll
                        for (int i = 0; i < 4; ++i) { const float z0 = a[i] + bf0[i], z1 = b[i] + bf1[i]; c0[i] = fminf(z0, 0.f) - log1pf(__expf(-fabsf(z0))); c1[i] = fminf(z1, 0.f) - log1pf(__expf(-fabsf(z1))); }
                        *(f32x4*)(LOGF + (size_t)er * 8) = c0; *(f32x4*)(LOGF + (size_t)er * 8 + 4) = c1;
                        float* o = nullptr; if (orow >= 0) o = out + O_LFP + (size_t)orow * 8; else if (orow != (int)0x80000000) o = out + O_LFS + (size_t)(-1 - orow) * 8;
                        if (o) { *(f32x4*)o = c0; *(f32x4*)(o + 4) = c1; } } }
                ss += __shfl_xor(ss, 16); ss += __shfl_xor(ss, 32); if (fq == 0) unsafeAtomicAdd(SSQ + row, ss); }
            else { unsigned char* p = (unsigned char*)GATES + (size_t)row * 2048 + (pn - 9) * 256 + cw;
                PG8_EACH_BJ { const f32x4 s0 = sig4(acc[ai][bj][m][0]) * 255.f + 0.5f, s1 = sig4(acc[ai][bj][m][1]) * 255.f + 0.5f;
                    *(u32x2*)(p + bj * HALF) = (u32x2){(unsigned)s0[0] | ((unsigned)s0[1] << 8) | ((unsigned)s0[2] << 16) | ((unsigned)s0[3] << 24), (unsigned)s1[0] | ((unsigned)s1[1] << 8) | ((unsigned)s1[2] << 16) | ((unsigned)s1[3] << 24)}; } }
            asm volatile("" ::: "memory");
        }
    }
};
struct EpiQ {
    static constexpr bool PERM = true, AFTER_DRAIN = false, MIDHOOK = false, PROBE2 = false;
    bf16_t* Q; const float* rope; const float* ssq;
    __device__ __forceinline__ void operator()(const f32x4 (&acc)[2][2][4][2], const Unit& u, int wr, int wc, int fr, int fq) const { PG8_RELANE;
        PG8_EACH_BJ { const int g32 = u.pn * 8 + bj * 4 + wc; const bool rp = (g32 % 3) == 2; const float sg = (fq < 2) ? -1.f : 1.f;
            PG8_EACH_AM { const int row = PG8_ROW(ai, m); const float rq = __builtin_amdgcn_rsqf(ssq[row] * (1.f / 384.f) + EPS) * (0.10206207261596575f * LOG2E);
                f32x4 v0 = acc[ai][bj][m][0] * rq, v1 = acc[ai][bj][m][1] * rq;
                if (rp) { const float* t = rope + ((size_t)::pos_of(row) * 16 + 8 * (fq & 1)) * 2;
                    const f32x4 t0 = *(const f32x4*)t, t1 = *(const f32x4*)(t + 4), t2 = *(const f32x4*)(t + 8), t3 = *(const f32x4*)(t + 12);
                    f32x4 q0, q1;
#pragma unroll
                    for (int i = 0; i < 4; ++i) { q0[i] = __shfl_xor(v0[i], 32); q1[i] = __shfl_xor(v1[i], 32); }
                    v0[0] = v0[0] * t0[0] + sg * q0[0] * t0[1]; v0[1] = v0[1] * t0[2] + sg * q0[1] * t0[3]; v0[2] = v0[2] * t1[0] + sg * q0[2] * t1[1]; v0[3] = v0[3] * t1[2] + sg * q0[3] * t1[3];
                    v1[0] = v1[0] * t2[0] + sg * q1[0] * t2[1]; v1[1] = v1[1] * t2[2] + sg * q1[1] * t2[3]; v1[2] = v1[2] * t3[0] + sg * q1[2] * t3[1]; v1[3] = v1[3] * t3[2] + sg * q1[3] * t3[3]; }
                *(u32x4*)(Q + (size_t)row * 768 + u.pn * BM + bj * HALF + wc * 32 + 8 * fq) = ::pk8(v0, v1); asm volatile("" ::: "memory"); } }
    }
};
struct EpiMixCat {
    static constexpr bool PERM = true, AFTER_DRAIN = false, MIDHOOK = true, PROBE2 = false;
    bf16_t* MIX; const unsigned char* GATES;
    static __device__ __forceinline__ f32x4 ub4(unsigned w) { return (f32x4){(float)(w & 0xffu), (float)((w >> 8) & 0xffu), (float)((w >> 16) & 0xffu), (float)(w >> 24)}; }
    __device__ __forceinline__ void mid(f32x4 (&acc)[2][2][4][2], const Unit& u, int wr, int wc, int fr, int fq) const { PG8_RELANE;
        const int colb = u.pn * BM + wc * 32 + 8 * fq;
        PG8_EACH_AM { const int row = PG8_ROW(ai, m);
            PG8_EACH_BJ { const unsigned char* gp = GATES + (size_t)row * 2048 + colb + bj * HALF; const u32x2 ga = *(const u32x2*)gp, gb = *(const u32x2*)(gp + 1024);
                f32x4 a0 = ub4(ga.x), a1 = ub4(ga.y), b0 = ub4(gb.x), b1 = ub4(gb.y);
#pragma unroll
                for (int i = 0; i < 4; ++i) { a0[i] *= __builtin_amdgcn_rcpf(fmaxf(b0[i], 0.25f)); a1[i] *= __builtin_amdgcn_rcpf(fmaxf(b1[i], 0.25f)); }
                acc[ai][bj][m][0] *= a0; acc[ai][bj][m][1] *= a1; }
            asm volatile("" ::: "memory"); }
    }
    __device__ __forceinline__ void operator()(const f32x4 (&acc)[2][2][4][2], const Unit& u, int wr, int wc, int fr, int fq) const { PG8_RELANE;
        const int colb = u.pn * BM + wc * 32 + 8 * fq;
        PG8_EACH_AM { const int row = PG8_ROW(ai, m);
            PG8_EACH_BJ { const int col = colb + bj * HALF; const u32x2 gb = *(const u32x2*)(GATES + (size_t)row * 2048 + 1024 + col);
                f32x4 b0 = ub4(gb.x), b1 = ub4(gb.y);
#pragma unroll
                for (int i = 0; i < 4; ++i) { b0[i] = fmaxf(b0[i], 0.25f) * (1.f / 255.f); b1[i] = fmaxf(b1[i], 0.25f) * (1.f / 255.f); }
                *(u32x4*)(MIX + (size_t)row * 1024 + col) = ::pk8(acc[ai][bj][m][0] * b0, acc[ai][bj][m][1] * b1); } }
    }
};
struct EpiH1 {
    static constexpr bool PERM = true, AFTER_DRAIN = false, MIDHOOK = false, PROBE2 = false;
    const float *xp, *meta, *xs; float* H1; bf16_t* H1B; float* SS;
    __device__ __forceinline__ void operator()(const f32x4 (&acc)[2][2][4][2], const Unit& u, int wr, int wc, int fr, int fq) const { PG8_RELANE;
        const int colb = u.pn * BM + wc * 32 + 8 * fq;
        PG8_EACH_AM { const int row = PG8_ROW(ai, m); const float* xr = nullptr;
            if (row >= MP) xr = xs + (size_t)(row - MP) * D; else { const int b = row / LP, tp = row - b * LP; if (tp >= 64) xr = xp + ((size_t)b * SEQ + (tp - 64)) * D; else if (tp >= PADR) xr = meta + (size_t)(tp - PADR) * D; }
            float ss = 0.f;
            PG8_EACH_BJ { const int col = colb + bj * HALF; f32x4 a = acc[ai][bj][m][0], b = acc[ai][bj][m][1];
                if (xr) { a += *(const f32x4*)(xr + col); b += *(const f32x4*)(xr + col + 4); }
                *(u32x4*)(H1B + (size_t)row * D + col) = ::pk8(a, b);
                ss += (a[0] * a[0] + a[1] * a[1]) + (a[2] * a[2] + a[3] * a[3]) + (b[0] * b[0] + b[1] * b[1]) + (b[2] * b[2] + b[3] * b[3]); }
            ss += __shfl_xor(ss, 16); ss += __shfl_xor(ss, 32);
            if (fq == 0) unsafeAtomicAdd(SS + row, ss); }
    }
};
struct EpiH2 {
    static constexpr bool PERM = true, AFTER_DRAIN = false, MIDHOOK = false, PROBE2 = false;
    bf16_t* HB; float* SS;
    __device__ __forceinline__ void operator()(const f32x4 (&acc)[2][2][4][2], const Unit& u, int wr, int wc, int fr, int fq) const { PG8_RELANE;
        const int colb = u.pn * BM + wc * 32 + 8 * fq;
        PG8_EACH_AM { const int row = PG8_ROW(ai, m); float ss = 0.f;
            PG8_EACH_BJ { bf16_t* p = HB + (size_t)row * D + colb + bj * HALF; const u32x4 o = *(const u32x4*)p;
                const f32x4 a = acc[ai][bj][m][0] + unlo((u32x2){o.x, o.y}), b = acc[ai][bj][m][1] + unlo((u32x2){o.z, o.w});
                *(u32x4*)p = ::pk8(a, b);
                ss += (a[0] * a[0] + a[1] * a[1]) + (a[2] * a[2] + a[3] * a[3]) + (b[0] * b[0] + b[1] * b[1]) + (b[2] * b[2] + b[3] * b[3]); }
            ss += __shfl_xor(ss, 16); ss += __shfl_xor(ss, 32);
            if (fq == 0) unsafeAtomicAdd(SS + row, ss); }
    }
};
template <bool SAMPLE> struct EpiConv {
    static constexpr bool PERM = true, AFTER_DRAIN = false, MIDHOOK = false, PROBE2 = true;
    bf16_t* G; const float* ss2; const float* convw; const float* convb; const float* state; float* out; int wrs;
    __device__ __forceinline__ void operator()(const f32x4 (&acc)[2][2][4][2], const Unit& u, int wr, int wc, int fr, int fq) const { PG8_RELANE;
        const int runbase = (SAMPLE ? MP : u.pm * 252) + wrs * wr, base = runbase + 8 * fr;
        float rs[8]; unsigned okm = 0u;
#pragma unroll
        for (int j = 0; j < 8; ++j) { const int tok = base + j;
            if (SAMPLE) { rs[j] = __builtin_amdgcn_rsqf(ss2[tok] * (1.f / D) + EPS); okm |= 1u << j; }
            else { const int tc = tok < MT ? tok : MT - 1; const bool v = tok < MP && (tc % LP) >= PADR; rs[j] = v ? __builtin_amdgcn_rsqf(ss2[tc] * (1.f / D) + EPS) : 0.f;
                if (tok < MP && (fr > 0 || j >= 2)) okm |= 1u << j; } }
        const int chb = u.pn * 128 + wc * 32 + 8 * fq;
        const int sb = 8 * wr + (fr >> 1);
        int eb = -1, etok = 0;
        if (!SAMPLE) { const int b = runbase / LP; etok = b * LP + LP - 2; if (b < NB && etok < runbase + 128) eb = b; }
        unsigned char* gb = (unsigned char*)G + (size_t)(unsigned)base * (DFF * 2);
#pragma unroll
        for (int n = 0; n < 2; ++n) { const int ch = chb + 4 * n; f32x4 cg[8];
#pragma unroll
            for (int bj = 0; bj < 2; ++bj) { const int cx = bj * DFF + ch;
                const f32x4 cb = *(const f32x4*)(convb + cx), w0 = *(const f32x4*)(convw + cx), w1 = *(const f32x4*)(convw + UPW + cx), w2 = *(const f32x4*)(convw + 2 * UPW + cx);
                f32x4 p1, p2;
                { const f32x4 u7 = acc[1][bj][3][n] * rs[7], u6 = acc[1][bj][2][n] * rs[6];
#pragma unroll
                    for (int e2 = 0; e2 < 4; ++e2) { p1[e2] = dpp_shr1(u7[e2]); p2[e2] = dpp_shr1(u6[e2]); }
                    if (SAMPLE) { if (fr & 1) { *(f32x4*)(out + O_CVS + ((size_t)sb * 2) * UPW + cx) = u6; *(f32x4*)(out + O_CVS + ((size_t)sb * 2 + 1) * UPW + cx) = u7; }
                        else { p1 = *(const f32x4*)(state + ((size_t)sb * 2 + 1) * UPW + cx); p2 = *(const f32x4*)(state + ((size_t)sb * 2) * UPW + cx); } } }
                if (!SAMPLE && eb >= 0) {
#pragma unroll
                    for (int j = 0; j < 8; ++j) { const int k = base + j - etok; if ((k == 0 || k == 1) && ((okm >> j) & 1u)) *(f32x4*)(out + O_CVP + ((size_t)eb * 2 + k) * UPW + cx) = acc[j >> 2][bj][j & 3][n] * rs[j]; } }
                f32x4 um2 = p2, um1 = p1;
#pragma unroll
                for (int j = 0; j < 8; ++j) { const f32x4 uj = acc[j >> 2][bj][j & 3][n] * rs[j];
                    const f32x4 c = cb + w0 * um2 + w1 * um1 + w2 * uj; um2 = um1; um1 = uj;
                    if (bj == 0) cg[j] = c;
                    else { const f32x4 o = cg[j] * sig4(cg[j]) * c;
                        if ((okm >> j) & 1u) *(u32x2*)(gb + j * (DFF * 2) + ch * 2) = (u32x2){::pk2(o[0], o[1]), ::pk2(o[2], o[3])}; } }
                asm volatile("" ::: "memory");
            } }
    }
};
template <class Epi, class Sched, bool ALIGN_EPI = false, bool SP2 = false>
__device__ __forceinline__ void gemm_phase(PG8_LAS unsigned char* lds, const Gemm g, const Sched& S, const Epi& E, const AMap am) {
    int tid_ = threadIdx.x; asm volatile("" : "+v"(tid_));
    const int tid = tid_, wid = __builtin_amdgcn_readfirstlane(tid >> 6), lane = tid & 63, wr = wid >> 2, wc = wid & 3, fr = lane & 15, fq = lane >> 4;
    int K_ = g.K; asm volatile("" : "+s"(K_)); const int K = K_, nt = K / BK;
    unsigned voffA[2], voffB[2];
#pragma unroll
    for (int i = 0; i < 2; ++i) { int R, C; stage_rc(tid * 16 + i * 8192, R, C); const int Rb = Epi::PERM ? ((R & ~31) + perm32(R & 31)) : R;
        voffA[i] = (unsigned)((am.perm ? (am.wrs * (R >> 6) + 8 * (R & 15) + ((R >> 4) & 3)) : R) * K + C) * 2u; voffB[i] = (unsigned)(Rb * K + C) * 2u; }
    const size_t kstep = (size_t)(BK * 2);
    const size_t hstep = (size_t)HALF * K * 2;
    const size_t tstep = 2 * hstep;
    const size_t hstepA = am.perm ? (size_t)4 * K * 2 : hstep; const size_t tstepA = (size_t)am.trows * K * 2;
    const unsigned ldsw = (unsigned)wid * 1024u;
    const int aoff = lds_byte(wr * 64 + fr, fq * 8), boff = lds_byte(wc * 32 + fr, fq * 8);
#define PG8_SA(b, h) (((b) * 2 + (h)) * HTB)
#define PG8_SB(b, h) ((4 + (b) * 2 + (h)) * HTB)
#define PG8_STAGE(bufoff, gbase, voff) do { _Pragma("unroll") for (int _i = 0; _i < 2; ++_i) \
        __builtin_amdgcn_global_load_lds((const unsigned*)((const char*)(gbase) + (voff)[_i]), (PG8_LAS unsigned*)(lds + (bufoff) + ldsw + _i * 8192), 16, 0, 0); } while (0)
#define PG8_LDA(dst, b, h) do { _Pragma("unroll") for (int m = 0; m < 4; ++m) _Pragma("unroll") for (int k = 0; k < 2; ++k) dst[m][k] = *(const PG8_LAS bf16x8*)(lds + PG8_SA(b, h) + aoff + m * 2048 + k * 1024); } while (0)
#define PG8_LDB(dst, b, h) do { _Pragma("unroll") for (int n = 0; n < 2; ++n) _Pragma("unroll") for (int k = 0; k < 2; ++k) dst[n][k] = *(const PG8_LAS bf16x8*)(lds + PG8_SB(b, h) + boff + n * 2048 + k * 1024); } while (0)
#define PG8_MMA(ai, bj, At, Bt) do { __builtin_amdgcn_s_setprio(1); _Pragma("unroll") for (int m = 0; m < 4; ++m) _Pragma("unroll") for (int n = 0; n < 2; ++n) _Pragma("unroll") for (int k = 0; k < 2; ++k) \
        acc[ai][bj][m][n] = __builtin_amdgcn_mfma_f32_16x16x32_bf16(Bt[n][k], At[m][k], acc[ai][bj][m][n], 0, 0, 0); __builtin_amdgcn_s_setprio(0); } while (0)
#define PG8_WAIT_V(n) asm volatile("s_waitcnt vmcnt(" #n ")" ::: "memory")
#define PG8_WAIT_L(n) asm volatile("s_waitcnt lgkmcnt(" #n ")" ::: "memory")
#define PG8_BAR __builtin_amdgcn_s_barrier()
#define PG8_SCHED __builtin_amdgcn_sched_barrier(0)
    Unit cur, nxt; int ui = 0;
    if (!S.next(0, cur)) return;
    f32x4 acc[2][2][4][2];
#pragma unroll
    for (int a = 0; a < 2; ++a)
#pragma unroll
        for (int b = 0; b < 2; ++b)
#pragma unroll
            for (int m = 0; m < 4; ++m)
#pragma unroll
                for (int n = 0; n < 2; ++n) acc[a][b][m][n] = (f32x4){0.f, 0.f, 0.f, 0.f};
    bf16x8 At[4][2], B0[2][2], B1[2][2];
    const char* cA = (const char*)g.A + (size_t)cur.pm * tstepA; const char* cB = (const char*)g.Bt + (size_t)cur.pn * tstep;
    S.a_ready(cur);
    if constexpr (SP2) {
        PG8_STAGE(PG8_SB(0, 0), cB, voffB); PG8_STAGE(PG8_SB(0, 1), cB + hstep, voffB); PG8_STAGE(PG8_SA(0, 0), cA, voffA); PG8_STAGE(PG8_SA(0, 1), cA + hstepA, voffA);
        if (wr == 1) PG8_BAR;
        PG8_WAIT_V(2); PG8_BAR;
        PG8_STAGE(PG8_SB(1, 0), cB + kstep, voffB); PG8_STAGE(PG8_SA(1, 0), cA + kstep, voffA); PG8_STAGE(PG8_SB(1, 1), cB + hstep + kstep, voffB);
        PG8_WAIT_V(6); PG8_BAR;
    } else {
        PG8_STAGE(PG8_SB(0, 0), cB, voffB); PG8_STAGE(PG8_SA(0, 0), cA, voffA); PG8_STAGE(PG8_SB(0, 1), cB + hstep, voffB); PG8_STAGE(PG8_SA(0, 1), cA + hstepA, voffA);
        if (wr == 1) PG8_BAR;
        PG8_WAIT_V(4); PG8_BAR;
        PG8_STAGE(PG8_SB(1, 0), cB + kstep, voffB); PG8_STAGE(PG8_SA(1, 0), cA + kstep, voffA); PG8_STAGE(PG8_SB(1, 1), cB + hstep + kstep, voffB);
        PG8_WAIT_V(6); PG8_BAR;
    }
    for (;;) {
        const bool has_next = S.next(ui + 1, nxt);
        const char* nA = has_next ? (const char*)g.A + (size_t)nxt.pm * tstepA : cA; const char* nB = has_next ? (const char*)g.Bt + (size_t)nxt.pn * tstep : cB;
        for (int t = 0; t < nt; t += 2) {
            const bool last = (t == nt - 2);
            const char* a1 = cA + (size_t)(t + 1) * kstep;
            const char* a2 = last ? nA : cA + (size_t)(t + 2) * kstep; const char* b2 = last ? nB : cB + (size_t)(t + 2) * kstep;
            const char* a3 = a2 + kstep; const char* b3 = b2 + kstep;
            if (last && has_next) S.a_ready(nxt);
            if constexpr (SP2) {
            PG8_LDB(B0, 0, 0); PG8_LDB(B1, 0, 1); PG8_SCHED; PG8_LDA(At, 0, 0); PG8_STAGE(PG8_SA(1, 1), a1 + hstepA, voffA);
            PG8_WAIT_V(8); PG8_WAIT_L(0); PG8_BAR; PG8_MMA(0, 0, At, B0); PG8_MMA(0, 1, At, B1); PG8_BAR; PG8_SCHED;
            PG8_LDA(At, 0, 1); PG8_STAGE(PG8_SB(0, 0), b2, voffB); PG8_STAGE(PG8_SB(0, 1), b2 + hstep, voffB); PG8_STAGE(PG8_SA(0, 0), a2, voffA);
            PG8_WAIT_V(8); PG8_WAIT_L(0); PG8_BAR; PG8_MMA(1, 0, At, B0); PG8_MMA(1, 1, At, B1); PG8_BAR; PG8_SCHED;
            PG8_LDB(B0, 1, 0); PG8_LDB(B1, 1, 1); PG8_SCHED; PG8_LDA(At, 1, 0); PG8_STAGE(PG8_SA(0, 1), a2 + hstepA, voffA);
            PG8_WAIT_V(8); PG8_WAIT_L(0); PG8_BAR; PG8_MMA(0, 0, At, B0); PG8_MMA(0, 1, At, B1); PG8_BAR; PG8_SCHED;
            PG8_LDA(At, 1, 1); PG8_STAGE(PG8_SB(1, 0), b3, voffB); PG8_STAGE(PG8_SB(1, 1), b3 + hstep, voffB); PG8_STAGE(PG8_SA(1, 0), a3, voffA);
            PG8_WAIT_V(8); PG8_WAIT_L(0); PG8_BAR; PG8_MMA(1, 0, At, B0); PG8_MMA(1, 1, At, B1); PG8_BAR; PG8_SCHED;
            if constexpr (Epi::MIDHOOK) { if (t + 2 == nt / 2) E.mid(acc, cur, wr, wc, fr, fq); }
            } else {
            PG8_LDB(B0, 0, 0); PG8_SCHED; PG8_LDA(At, 0, 0); PG8_STAGE(PG8_SA(1, 1), a1 + hstepA, voffA);
            PG8_WAIT_L(8); PG8_BAR; PG8_WAIT_L(0); PG8_MMA(0, 0, At, B0); PG8_BAR; PG8_SCHED;
            PG8_LDB(B1, 0, 1); PG8_STAGE(PG8_SB(0, 0), b2, voffB);
            PG8_BAR; PG8_WAIT_L(0); PG8_MMA(0, 1, At, B1); PG8_BAR;
            PG8_LDA(At, 0, 1); PG8_STAGE(PG8_SA(0, 0), a2, voffA);
            PG8_BAR; PG8_WAIT_L(0); PG8_MMA(1, 0, At, B0); PG8_BAR; PG8_SCHED;
            PG8_STAGE(PG8_SB(0, 1), b2 + hstep, voffB);
            PG8_WAIT_V(6); PG8_BAR; PG8_MMA(1, 1, At, B1); PG8_BAR;
            PG8_LDB(B0, 1, 0); PG8_SCHED; PG8_LDA(At, 1, 0); PG8_STAGE(PG8_SA(0, 1), a2 + hstepA, voffA);
            PG8_WAIT_L(8); PG8_BAR; PG8_WAIT_L(0); PG8_MMA(0, 0, At, B0); PG8_BAR; PG8_SCHED;
            PG8_LDB(B1, 1, 1); PG8_STAGE(PG8_SB(1, 0), b3, voffB);
            PG8_BAR; PG8_WAIT_L(0); PG8_MMA(0, 1, At, B1); PG8_BAR;
            PG8_LDA(At, 1, 1); PG8_STAGE(PG8_SA(1, 0), a3, voffA);
            PG8_BAR; PG8_WAIT_L(0); PG8_MMA(1, 0, At, B0); PG8_BAR; PG8_SCHED;
            PG8_STAGE(PG8_SB(1, 1), b3 + hstep, voffB);
            PG8_WAIT_V(6); PG8_BAR; PG8_MMA(1, 1, At, B1); PG8_BAR;
            }
        }
        if constexpr (ALIGN_EPI) { if (wr == 0) PG8_BAR; }
        if constexpr (!Epi::AFTER_DRAIN) { E(acc, cur, wr, wc, fr, fq);
#ifdef PROBE_EPI2
            if constexpr (Epi::PROBE2) { asm volatile("" ::: "memory"); E(acc, cur, wr, wc, fr, fq); }
#endif
            S.done(cur); }
        if (!has_next) break;
#pragma unroll
        for (int a = 0; a < 2; ++a)
#pragma unroll
            for (int b = 0; b < 2; ++b)
#pragma unroll
                for (int m = 0; m < 4; ++m)
#pragma unroll
                    for (int n = 0; n < 2; ++n) acc[a][b][m][n] = (f32x4){0.f, 0.f, 0.f, 0.f};
        cur = nxt; cA = nA; cB = nB; ++ui;
        if constexpr (ALIGN_EPI) { if (wr == 1) PG8_BAR; }
    }
    PG8_WAIT_V(0);
    if constexpr (!ALIGN_EPI) { if (wr == 0) PG8_BAR; }
    PG8_BAR;
    if constexpr (Epi::AFTER_DRAIN) { E.fused(acc, cur, wr, wc, fr, fq, lds, wid, lane); S.done(cur); }
#undef PG8_SA
#undef PG8_SB
#undef PG8_STAGE
#undef PG8_LDA
#undef PG8_LDB
#undef PG8_MMA
#undef PG8_WAIT_V
#undef PG8_WAIT_L
#undef PG8_BAR
#undef PG8_SCHED
}
}

__device__ __forceinline__ void tr_item(const float* W, int Nsrc, int K, bf16* WT, int drow0, int scol0, int nvalid, const float* kscale, LAS float* scr, int kb, int lane, int koff = 0) {
    const int k0 = 64 * kb;
#pragma unroll 16
    for (int i = 0; i < 32; ++i) { const int kk = 2 * i + (lane >> 5), c = lane & 31; float v = 0.f;
        if (c < nvalid) v = W[(size_t)(k0 + kk) * Nsrc + scol0 + c];
        if (kscale) v *= kscale[k0 + kk];
        scr[kk * 33 + c] = v; }
    LDS_WAIT(); asm volatile("" ::: "memory");
    const int c8 = lane & 7;
#pragma unroll
    for (int j = 0; j < 4; ++j) { const int n = (lane >> 3) + 8 * j; const LAS float* s = scr + (8 * c8) * 33 + n;
        u32x4 o; o.x = pk2(s[0 * 33], s[1 * 33]); o.y = pk2(s[2 * 33], s[3 * 33]); o.z = pk2(s[4 * 33], s[5 * 33]); o.w = pk2(s[6 * 33], s[7 * 33]);
        *(u32x4*)(WT + (size_t)(drow0 + n) * K + koff + k0 + 8 * c8) = o; }
    LDS_WAIT(); asm volatile("" ::: "memory");
}
__device__ __forceinline__ const float* x_row_ptr(int m, const float* xp, const float* meta, const float* xs) {
    if (m >= MP) return xs + (size_t)(m - MP) * D;
    const int b = m / LP, tp = m - b * LP;
    if (tp >= 64) return xp + ((size_t)b * SEQ + (tp - 64)) * D;
    if (tp >= PADR) return meta + (size_t)(tp - PADR) * D;
    return nullptr;
}
__device__ __forceinline__ void p0_prologue(const KArgs& a, LAS unsigned char* lds, int gw, int NGW, int wave, int lane, int gtid, int NT) {
    unsigned char* ws = a.ws;
    LAS float* scr = (LAS float*)(lds + wave * 16384);
    constexpr int I0 = 16 * 136, I1 = I0 + 6 * 24, I2 = I1 + 4 * 32, I3 = I2 + 8 * 32, I4 = I3 + 8 * 32, I5 = I4 + 16 * 32, I6 = I5 + 16 * 176, I7 = I6 + 44 * 32;
    for (int it = gw; it < I7; it += NGW) {
        if (it < I0) { const int kb = it / 136, g = it % 136, n0 = 32 * g; int sc, nv = 32;
            if (n0 < 1536) sc = n0;
            else if (n0 < 2304) { const int j = n0 - 1536; if (j < 384) sc = OFF_CQ + j; else if (j == 384) sc = OFF_KR; else if (j == 416) { sc = OFF_FF; nv = 8; } else if (j < 512) { sc = 0; nv = 0; } else sc = OFF_CKV + (j - 512); }
            else sc = OFF_GATE + (n0 - 2304);
            tr_item(a.in[10], INW, D, (bf16*)(ws + W_WIN), n0, sc, nv, nullptr, scr, kb, lane); }
        else if (it < I1) { const int r = it - I0, kb = r / 24, g = r % 24; tr_item(a.in[13], 768, 384, (bf16*)(ws + W_WUQ), 32 * g, 32 * g, 32, a.in[12], scr, kb, lane); }
        else if (it < I2) { const int r = it - I1, kb = r / 32, g = r % 32; tr_item(a.in[15], 1024, 256, (bf16*)(ws + W_WUKV), 32 * g, 32 * g, 32, nullptr, scr, kb, lane); }
        else if (it < I3) { const int r = it - I2, kb = r / 32, g = r % 32; tr_item(a.in[16], 1024, 1024, (bf16*)(ws + W_WOC), 32 * g, 32 * g, 32, nullptr, scr, kb, lane, 0); }
        else if (it < I4) { const int r = it - I3, kb = r / 32, g = r % 32; tr_item(a.in[17], 1024, 1024, (bf16*)(ws + W_WOC), 32 * g, 32 * g, 32, nullptr, scr, kb, lane, 512); }
        else if (it < I5) { const int r = it - I4, kb = r / 32, g = r % 32; tr_item(a.in[18], 1024, 1024, (bf16*)(ws + W_WOUT), 32 * g, 32 * g, 32, nullptr, scr, kb, lane); }
        else if (it < I6) { const int r = it - I5, kb = r / 176, g = r % 176, n0 = 32 * g, pn = n0 >> 8, jj = n0 & 255, bj = jj >> 7, ch = 128 * pn + (jj & 127);
            tr_item(a.in[20], UPW, D, (bf16*)(ws + W_WUP), n0, bj * DFF + ch, 32, a.in[19], scr, kb, lane); }
        else { const int r = it - I6, kb = r / 32, g = r % 32; tr_item(a.in[23], 1024, DFF, (bf16*)(ws + W_WDN), 32 * g, 32 * g, 32, nullptr, scr, kb, lane); }
    }
    { const float* gm = a.in[9]; f32x4 gv[4];
#pragma unroll
        for (int j = 0; j < 4; ++j) gv[j] = *(const f32x4*)(gm + 4 * lane + 256 * j);
        bf16* XN = (bf16*)(ws + W_XN);
        for (int m0 = 4 * gw; m0 < MT; m0 += 4 * NGW) {
            f32x4 v[4][4]; float s[4];
#pragma unroll
            for (int q = 0; q < 4; ++q) { const float* xr = x_row_ptr(m0 + q, a.in[0], a.in[8], a.in[1]);
#pragma unroll
                for (int j = 0; j < 4; ++j) v[q][j] = xr ? *(const f32x4*)(xr + 4 * lane + 256 * j) : (f32x4){0.f, 0.f, 0.f, 0.f}; }
#pragma unroll
            for (int q = 0; q < 4; ++q) { s[q] = 0.f;
#pragma unroll
                for (int j = 0; j < 4; ++j) s[q] += (v[q][j][0] * v[q][j][0] + v[q][j][1] * v[q][j][1]) + (v[q][j][2] * v[q][j][2] + v[q][j][3] * v[q][j][3]); }
#pragma unroll
            for (int q = 0; q < 4; ++q) { const float r = __builtin_amdgcn_rsqf(wave_sum(s[q]) * (1.f / D) + EPS);
#pragma unroll
                for (int j = 0; j < 4; ++j) { const f32x4 o = v[q][j] * r * gv[j]; *(u32x2*)(XN + (size_t)(m0 + q) * D + 4 * lane + 256 * j) = (u32x2){pk2(o[0], o[1]), pk2(o[2], o[3])}; } } } }
    { bf16* FK = (bf16*)(ws + W_FK); bf16* FV = (bf16*)(ws + W_FV);
        for (int t0 = gw; t0 < SB * SXR; t0 += 2 * NGW) {
            u32x4 k[2], v[2]; bool wr_[2];
#pragma unroll
            for (int q = 0; q < 2; ++q) { const int t = t0 + q * NGW; k[q] = (u32x4){0u, 0u, 0u, 0u}; v[q] = k[q]; wr_[q] = false;
                if (t < SB * SXR) { const int sb = t / SXR, j = t - sb * SXR; wr_[q] = !(j >= PAST && j < PAST + SN);
                    if (j < PAST) { const size_t src = ((size_t)sb * PAST + j) * 512 + 8 * lane; k[q] = pk8(*(const f32x4*)(a.in[2] + src), *(const f32x4*)(a.in[2] + src + 4)); v[q] = pk8(*(const f32x4*)(a.in[3] + src), *(const f32x4*)(a.in[3] + src + 4)); } } }
#pragma unroll
            for (int q = 0; q < 2; ++q) if (wr_[q]) { const size_t er = (size_t)(MP + t0 + q * NGW) * 512 + 8 * lane; *(u32x4*)(FK + er) = k[q]; *(u32x4*)(FV + er) = v[q]; } } }
    { bf16* CKVN = (bf16*)(ws + W_CKVN); bf16* KR = (bf16*)(ws + W_KR); float* LOGF = (float*)(ws + W_LOGF);
    for (int t = gw; t < SB * SXR; t += NGW) { const int sb = t / SXR, j = t - sb * SXR; if (j >= PAST && j < PAST + SN) continue;
        const size_t er = (size_t)(MP + t); const bool c = j < PAST; const size_t sr = (size_t)sb * PAST + j;
        { f32x4 v = {0.f, 0.f, 0.f, 0.f}; if (c) v = *(const f32x4*)(a.in[5] + sr * 256 + 4 * lane); *(u32x2*)(CKVN + er * 256 + 4 * lane) = (u32x2){pk2(v[0], v[1]), pk2(v[2], v[3])}; }
        if (lane < 8) { f32x4 v = {0.f, 0.f, 0.f, 0.f}; if (c) v = *(const f32x4*)(a.in[6] + sr * 32 + 4 * lane); *(u32x2*)(KR + er * 32 + 4 * lane) = (u32x2){pk2(v[0], v[1]), pk2(v[2], v[3])}; }
        if (lane < 2) { f32x4 v = {0.f, 0.f, 0.f, 0.f}; if (c) v = *(const f32x4*)(a.in[4] + sr * 8 + 4 * lane); *(f32x4*)(LOGF + er * 8 + 4 * lane) = v; } }
    }
    { float* s2 = (float*)(ws + W_SS2); float* s3 = (float*)(ws + W_SS3); float* sq = (float*)(ws + W_SSQ); for (int i = gtid; i < MT; i += NT) { s2[i] = 0.f; s3[i] = 0.f; sq[i] = 0.f; }
        float* rp = (float*)(ws + W_ROPE);
        for (int i = gtid; i < LSEQ * 16; i += NT) { const int pos = i >> 4, k = i & 15; const float inv = exp2f(-(float)k * (13.287712379549449f / 16.f)); const float ang = (float)pos * inv;
            const double rev = (double)ang * 0.15915494309189535; const double fr = rev - __builtin_rint(rev); const float f = (float)fr;
            rp[2 * i] = __builtin_amdgcn_cosf(f); rp[2 * i + 1] = __builtin_amdgcn_sinf(f); } }
}
__device__ __forceinline__ void p3_scan(const KArgs& a, int gw, int NGW, int lane) {
    const float* LOGF = (const float*)(a.ws + W_LOGF); float* FB = (float*)(a.ws + W_FB);
    for (int s = gw; s < NB * NH + SB * NH; s += NGW) { int base, nch, h;
        if (s < NB * NH) { base = (s >> 3) * LP; nch = LP / 64; h = s & 7; } else { const int t = s - NB * NH; base = MP + (t >> 3) * SXR; nch = SXR / 64; h = t & 7; }
        float carry = 0.f;
        for (int c = 0; c < nch; ++c) { float v = LOGF[(size_t)(base + 64 * c + lane) * 8 + h];
#pragma unroll
            for (int o = 1; o < 64; o <<= 1) { const float t = __shfl_up(v, o); if (lane >= o) v += t; }
            v += carry; FB[(size_t)h * ER + base + 64 * c + lane] = -v * LOG2E; carry = __shfl(v, 63); } }
}
__device__ __forceinline__ void p9_final(const KArgs& a, int gw, int NGW, int lane, int G, int which) {
    const bf16* H = (const bf16*)(a.ws + W_H1B); const float* SS = (const float*)(a.ws + W_SS3); const float* g = a.in[24]; f32x4 gv[4];
#pragma unroll
    for (int j = 0; j < 4; ++j) gv[j] = *(const f32x4*)(g + 4 * lane + 256 * j);
    pg8::StaticOrder S; S.init(MT, D, G, 0); const int lim = (S.nwg / G) * G, ntail = S.nwg - lim;
    int tpm = -1; if (lane < ntail) { pg8::Unit u; S.map(lim + lane, u); tpm = u.pm; }
    for (int m = 4 * gw; m < MT; m += 4 * NGW) { float* o;
        { const bool tl = __ballot(tpm == (m >> 8)) != 0ull; if (tl != (which == 1)) continue; }
        if (m >= MP) o = a.out + O_YS + (size_t)(m - MP) * D; else { const int b = m / LP, tp = m - b * LP; if (tp < 64) continue; o = a.out + O_YP + ((size_t)b * SEQ + (tp - 64)) * D; }
        u32x2 w[4][4]; float rs[4];
#pragma unroll
        for (int q = 0; q < 4; ++q) { rs[q] = __builtin_amdgcn_rsqf(SS[m + q] * (1.f / D) + EPS);
#pragma unroll
            for (int j = 0; j < 4; ++j) w[q][j] = *(const u32x2*)(H + (size_t)(m + q) * D + 4 * lane + 256 * j); }
#pragma unroll
        for (int q = 0; q < 4; ++q)
#pragma unroll
            for (int j = 0; j < 4; ++j) *(f32x4*)(o + (size_t)q * D + 4 * lane + 256 * j) = (f32x4){bflo(w[q][j].x), bfhi(w[q][j].x), bflo(w[q][j].y), bfhi(w[q][j].y)} * rs[q] * gv[j]; }
}

struct AttnP { const bf16* Q; const bf16* K1; const bf16* K2; const bf16* V; const float* FB; bf16* O; float* okp; float* ovp; int qpitch, k1pitch, vpitch, opitch, ntiles, q0, nq, cmode, kvlo, qlo, kvhi; float sl2; };
typedef short v4i16_t __attribute__((ext_vector_type(4)));
#define MFMA32(a, b, c) __builtin_amdgcn_mfma_f32_32x32x16_bf16((a), (b), (c), 0, 0, 0)
template <int DK, bool FOX, int BOFF> __device__ __forceinline__ void attn_qk(LAS unsigned char* kl  , const bf16x8 (&qf)[DK / 16], f32x16& p0, f32x16& p1, int lane) {
    constexpr int KP = DK == 64 ? 144 : 208, ND = DK / 16, NF = ND + (FOX ? 1 : 0);
    const int h = lane >> 5;
    bf16x8 ka[NF], kc[NF];
#pragma unroll
    for (int d0 = 0; d0 < ND; ++d0) { ka[d0] = *(const LAS bf16x8*)(kl + BOFF + 32 * d0); kc[d0] = *(const LAS bf16x8*)(kl + BOFF + 32 * KP + 32 * d0); }
    if (FOX) { LAS unsigned char* ka_ = kl - 16 * h + 128; ka[NF - 1] = *(const LAS bf16x8*)(ka_ + BOFF); kc[NF - 1] = *(const LAS bf16x8*)(ka_ + BOFF + 32 * KP); }
    __builtin_amdgcn_sched_barrier(0);
#pragma unroll
    for (int d0 = 0; d0 < ND; ++d0) {
        if (d0 == 0) { f32x16 z;
#pragma unroll
            for (int i = 0; i < 16; ++i) z[i] = 0.f;
            p0 = MFMA32(ka[0], qf[0], z); p1 = MFMA32(kc[0], qf[0], z); } else { p0 = MFMA32(ka[d0], qf[d0], p0); p1 = MFMA32(kc[d0], qf[d0], p1); } }
    if (FOX) { const short one = h == 0 ? (short)0x3F80 : (short)0; const bf16x8 qa = {one, one, one, 0, 0, 0, 0, 0};
        p0 = MFMA32(ka[NF - 1], qa, p0); p1 = MFMA32(kc[NF - 1], qa, p1); }
}
template <int BOFF> __device__ __forceinline__ void attn_sm_pv(LAS unsigned char* vl  , f32x16& p0, f32x16& p1, f32x16& o0, f32x16& o1, float& m_ref, float& l_run,
                                           bool first, int kvbase, bool needmask, int lo_l, int hi_l, int lane) {
    constexpr int VP = 144;
    const int h = lane >> 5;
    s16x4 vlo[8], vhi[8];
    {
#pragma unroll
        for (int k = 0; k < 4; ++k)
#pragma unroll
            for (int db = 0; db < 2; ++db) {
                vlo[2 * k + db] = __builtin_bit_cast(s16x4, __builtin_amdgcn_ds_read_tr16_b64_v4i16((LAS v4i16_t*)(vl + BOFF + (16 * k) * VP + 64 * db)));
                vhi[2 * k + db] = __builtin_bit_cast(s16x4, __builtin_amdgcn_ds_read_tr16_b64_v4i16((LAS v4i16_t*)(vl + BOFF + (16 * k + 8) * VP + 64 * db))); } }
    __builtin_amdgcn_sched_barrier(0);
    if (needmask) {
#pragma unroll
        for (int i = 0; i < 16; ++i) { const int kv = kvbase + (i & 3) + 8 * (i >> 2) + 4 * h;
            if (kv < lo_l || kv > hi_l) p0[i] = -INFINITY;
            if (kv + 32 < lo_l || kv + 32 > hi_l) p1[i] = -INFINITY; } }
    float ma = fmaxf(fmaxf(p0[0], p0[1]), p1[0]), mb = fmaxf(fmaxf(p0[2], p0[3]), p1[1]);
    ma = fmaxf(fmaxf(ma, p1[2]), p1[3]);
#pragma unroll
    for (int i = 4; i < 16; i += 4) { ma = fmaxf(fmaxf(ma, p0[i]), p0[i + 1]); mb = fmaxf(fmaxf(mb, p0[i + 2]), p0[i + 3]); ma = fmaxf(fmaxf(ma, p1[i]), p1[i + 1]); mb = fmaxf(fmaxf(mb, p1[i + 2]), p1[i + 3]); }
    float mx = fmaxf(ma, mb);
    { const auto rr = __builtin_amdgcn_permlane32_swap(__float_as_uint(mx), __float_as_uint(mx), false, false); mx = fmaxf(__uint_as_float(rr[0]), __uint_as_float(rr[1])); }
    const bool need = first || (mx - m_ref) > 8.f;
    if (__any(need)) { float dl = first ? mx : fmaxf(mx - m_ref, 0.f); if (!need || dl == -INFINITY) dl = 0.f;
        m_ref += dl; const float alpha = __builtin_amdgcn_exp2f(-dl); l_run *= alpha;
#pragma unroll
        for (int i = 0; i < 16; ++i) { o0[i] *= alpha; o1[i] *= alpha; } }
    float ps = 0.f, pt = 0.f;
#pragma unroll
    for (int i = 0; i < 16; ++i) { p0[i] = __builtin_amdgcn_exp2f(p0[i] - m_ref); p1[i] = __builtin_amdgcn_exp2f(p1[i] - m_ref); ps += p0[i]; pt += p1[i]; }
    l_run += ps + pt;
    bf16x8 pf[4];
#pragma unroll
    for (int s2 = 0; s2 < 2; ++s2) {
        u32x4 w0 = {pk2(p0[8 * s2], p0[8 * s2 + 1]), pk2(p0[8 * s2 + 2], p0[8 * s2 + 3]), pk2(p0[8 * s2 + 4], p0[8 * s2 + 5]), pk2(p0[8 * s2 + 6], p0[8 * s2 + 7])};
        u32x4 w1 = {pk2(p1[8 * s2], p1[8 * s2 + 1]), pk2(p1[8 * s2 + 2], p1[8 * s2 + 3]), pk2(p1[8 * s2 + 4], p1[8 * s2 + 5]), pk2(p1[8 * s2 + 6], p1[8 * s2 + 7])};
        pf[s2] = __builtin_bit_cast(bf16x8, w0); pf[2 + s2] = __builtin_bit_cast(bf16x8, w1); }
#pragma unroll
    for (int k = 0; k < 4; ++k) {
        const bf16x8 v0 = __builtin_shufflevector(vlo[2 * k], vhi[2 * k], 0, 1, 2, 3, 4, 5, 6, 7), v1 = __builtin_shufflevector(vlo[2 * k + 1], vhi[2 * k + 1], 0, 1, 2, 3, 4, 5, 6, 7);
        o0 = MFMA32(v0, pf[k], o0); o1 = MFMA32(v1, pf[k], o1); }
}
#ifndef SGV
#define SGV 8
#endif
template <int DK, bool FOX, int KOFF, int VOFF> __device__ __forceinline__ void attn_fused(LAS unsigned char* kl, LAS unsigned char* vl, const bf16x8 (&qf)[DK / 16], f32x16& p0, f32x16& p1, f32x16& pn0, f32x16& pn1,
                                                                                        f32x16& o0, f32x16& o1, float& m_ref, float& l_run, bool first, int kvbase, bool needmask, int lo_l, int hi_l, int lane) {
    constexpr int KP = DK == 64 ? 144 : 208, VP = 144, ND = DK / 16, NF = ND + (FOX ? 1 : 0);
    const int h = lane >> 5;
    bf16x8 ka[NF], kc[NF];
#pragma unroll
    for (int d0 = 0; d0 < ND; ++d0) { ka[d0] = *(const LAS bf16x8*)(kl + KOFF + 32 * d0); kc[d0] = *(const LAS bf16x8*)(kl + KOFF + 32 * KP + 32 * d0); }
    if (FOX) { LAS unsigned char* ka_ = kl - 16 * h + 128; ka[NF - 1] = *(const LAS bf16x8*)(ka_ + KOFF); kc[NF - 1] = *(const LAS bf16x8*)(ka_ + KOFF + 32 * KP); }
    if (needmask) {
#pragma unroll
        for (int i = 0; i < 16; ++i) { const int kv = kvbase + (i & 3) + 8 * (i >> 2) + 4 * h;
            if (kv < lo_l || kv > hi_l) p0[i] = -INFINITY;
            if (kv + 32 < lo_l || kv + 32 > hi_l) p1[i] = -INFINITY; } }
    float ma = fmaxf(fmaxf(p0[0], p0[1]), p1[0]), mb = fmaxf(fmaxf(p0[2], p0[3]), p1[1]);
    ma = fmaxf(fmaxf(ma, p1[2]), p1[3]);
#pragma unroll
    for (int i = 4; i < 16; i += 4) { ma = fmaxf(fmaxf(ma, p0[i]), p0[i + 1]); mb = fmaxf(fmaxf(mb, p0[i + 2]), p0[i + 3]); ma = fmaxf(fmaxf(ma, p1[i]), p1[i + 1]); mb = fmaxf(fmaxf(mb, p1[i + 2]), p1[i + 3]); }
    float mx = fmaxf(ma, mb);
    { const auto rr = __builtin_amdgcn_permlane32_swap(__float_as_uint(mx), __float_as_uint(mx), false, false); mx = fmaxf(__uint_as_float(rr[0]), __uint_as_float(rr[1])); }
    const bool need = first || (mx - m_ref) > 8.f;
    float dl = first ? mx : fmaxf(mx - m_ref, 0.f); if (!need || dl == -INFINITY) dl = 0.f;
    m_ref += dl; const float alpha = __builtin_amdgcn_exp2f(-dl); l_run *= alpha;
    __builtin_amdgcn_sched_barrier(0);
    float ps = 0.f, pt = 0.f;
#pragma unroll
    for (int g = 0; g < NF; ++g) {
        if (g < ND) { if (g == 0) { f32x16 z;
#pragma unroll
                for (int i = 0; i < 16; ++i) z[i] = 0.f;
                pn0 = MFMA32(ka[0], qf[0], z); } else pn0 = MFMA32(ka[g < ND ? g : 0], qf[g < ND ? g : 0], pn0); }
        else { const short one = h == 0 ? (short)0x3F80 : (short)0; const bf16x8 qa = {one, one, one, 0, 0, 0, 0, 0}; pn0 = MFMA32(ka[NF - 1], qa, pn0); }
#pragma unroll
        for (int i = (16 * g) / NF; i < (16 * (g + 1)) / NF; ++i) { o0[i] *= alpha;
#ifdef PROBE_EXP
            { float d_ = __builtin_amdgcn_exp2f(p0[i] - m_ref + 1.f); asm volatile("" :: "v"(d_)); }
#endif
            p0[i] = __builtin_amdgcn_exp2f(p0[i] - m_ref); ps += p0[i]; }
        __builtin_amdgcn_sched_barrier(0);
        if (g < ND) { if (g == 0) { f32x16 z;
#pragma unroll
                for (int i = 0; i < 16; ++i) z[i] = 0.f;
                pn1 = MFMA32(kc[0], qf[0], z); } else pn1 = MFMA32(kc[g < ND ? g : 0], qf[g < ND ? g : 0], pn1); }
        else { const short one = h == 0 ? (short)0x3F80 : (short)0; const bf16x8 qa = {one, one, one, 0, 0, 0, 0, 0}; pn1 = MFMA32(kc[NF - 1], qa, pn1); }
#pragma unroll
        for (int i = (16 * g) / NF; i < (16 * (g + 1)) / NF; ++i) { o1[i] *= alpha;
#ifdef PROBE_EXP
            { float d_ = __builtin_amdgcn_exp2f(p1[i] - m_ref + 1.f); asm volatile("" :: "v"(d_)); }
#endif
            p1[i] = __builtin_amdgcn_exp2f(p1[i] - m_ref); pt += p1[i]; }
        __builtin_amdgcn_sched_barrier(0);
    }
    l_run += ps + pt;
    __builtin_amdgcn_sched_barrier(0);
    s16x4 vlo[8], vhi[8];
#pragma unroll
    for (int k = 0; k < 4; ++k)
#pragma unroll
        for (int db = 0; db < 2; ++db) {
            vlo[2 * k + db] = __builtin_bit_cast(s16x4, __builtin_amdgcn_ds_read_tr16_b64_v4i16((LAS v4i16_t*)(vl + VOFF + (16 * k) * VP + 64 * db)));
            vhi[2 * k + db] = __builtin_bit_cast(s16x4, __builtin_amdgcn_ds_read_tr16_b64_v4i16((LAS v4i16_t*)(vl + VOFF + (16 * k + 8) * VP + 64 * db))); }
    bf16x8 pf[4];
#pragma unroll
    for (int s2 = 0; s2 < 2; ++s2) {
        u32x4 w0 = {pk2(p0[8 * s2], p0[8 * s2 + 1]), pk2(p0[8 * s2 + 2], p0[8 * s2 + 3]), pk2(p0[8 * s2 + 4], p0[8 * s2 + 5]), pk2(p0[8 * s2 + 6], p0[8 * s2 + 7])};
        u32x4 w1 = {pk2(p1[8 * s2], p1[8 * s2 + 1]), pk2(p1[8 * s2 + 2], p1[8 * s2 + 3]), pk2(p1[8 * s2 + 4], p1[8 * s2 + 5]), pk2(p1[8 * s2 + 6], p1[8 * s2 + 7])};
        pf[s2] = __builtin_bit_cast(bf16x8, w0); pf[2 + s2] = __builtin_bit_cast(bf16x8, w1); }
#pragma unroll
    for (int k = 0; k < 4; ++k) {
        const bf16x8 v0 = __builtin_shufflevector(vlo[2 * k], vhi[2 * k], 0, 1, 2, 3, 4, 5, 6, 7), v1 = __builtin_shufflevector(vlo[2 * k + 1], vhi[2 * k + 1], 0, 1, 2, 3, 4, 5, 6, 7);
        o0 = MFMA32(v0, pf[k], o0); o1 = MFMA32(v1, pf[k], o1); }
}
template <int DK, bool FOX> __device__ __forceinline__ void attn_unit(LAS unsigned char* lds, const AttnP& P) {
    constexpr int KP = DK == 64 ? 144 : 208, VP = 144, KBYTES = 64 * KP, VBYTES = 64 * VP, ND = DK / 16;
    int tid_ = threadIdx.x; asm volatile("" : "+v"(tid_));
    const int tid = tid_, lane = tid & 63, wid = __builtin_amdgcn_readfirstlane(tid >> 6), r = lane & 31, h = lane >> 5;
    const int lrow = tid >> 3, lch = tid & 7;
    LAS unsigned char* KB = lds; LAS unsigned char* VB = lds + 2 * KBYTES;
    LAS unsigned char* kl = KB + r * KP + 16 * h; LAS unsigned char* vl = VB + (4 * h + ((lane & 15) >> 2)) * VP + 32 * ((lane >> 4) & 1) + 8 * (lane & 3);
    const int q_abs = P.q0 + 32 * wid + r;
    const int qlim = P.cmode == 1 ? q_abs : (P.cmode == 2 ? (q_abs | 63) : 0x7fffffff);
    const int hi_l = qlim < P.kvhi - 1 ? qlim : P.kvhi - 1, lo_l = q_abs >= P.qlo ? P.kvlo : 0;
    const int qa0 = P.q0 + 32 * wid, qa1 = qa0 + 31;
    const int ql0 = P.cmode == 1 ? qa0 : (P.cmode == 2 ? (qa0 | 63) : 0x7fffffff), ql1 = P.cmode == 1 ? qa1 : (P.cmode == 2 ? (qa1 | 63) : 0x7fffffff);
    const int mnh = ql0 < P.kvhi - 1 ? ql0 : P.kvhi - 1, mxh = ql1 < P.kvhi - 1 ? ql1 : P.kvhi - 1, mxl = qa1 >= P.qlo ? P.kvlo : 0;
    const bool active = 32 * wid < P.nq;
    const int last_tile = (mxh >> 6) < P.ntiles - 1 ? (mxh >> 6) : P.ntiles - 1;
    bf16x8 qf[ND];
#pragma unroll
    for (int d0 = 0; d0 < ND; ++d0) { if (active) qf[d0] = *(const bf16x8*)(P.Q + (size_t)(32 * wid + r) * P.qpitch + 16 * d0 + 8 * h); else qf[d0] = (bf16x8){0, 0, 0, 0, 0, 0, 0, 0}; }
    float m_ref = 0.f, l_run = 0.f; f32x16 o0, o1, p0, p1, pn0, pn1;
#pragma unroll
    for (int i = 0; i < 16; ++i) { o0[i] = 0.f; o1[i] = 0.f; p0[i] = 0.f; p1[i] = 0.f; pn0[i] = 0.f; pn1[i] = 0.f; }
    u32x4 ak1 = {0u, 0u, 0u, 0u}, ak2 = {0u, 0u, 0u, 0u}, av = {0u, 0u, 0u, 0u}; float afb = 0.f;
#define A_LOADK(S, jt) do { S##k1 = *(const u32x4*)(P.K1 + (size_t)((jt) * 64 + lrow) * P.k1pitch + lch * 8); \
        if (DK == 96) S##k2 = *(const u32x4*)(P.K2 + (size_t)((jt) * 64 + ((tid >> 2) & 63)) * 32 + (tid & 3) * 8); \
        if (FOX) S##fb = P.FB[(jt) * 64 + (tid & 63)]; } while (0)
#define A_LOADV(S, jt) do { S##v = *(const u32x4*)(P.V + (size_t)((jt) * 64 + lrow) * P.vpitch + lch * 8); } while (0)
#define A_OUT8(ptr, VV, jt) do { if (FOX && (ptr) != nullptr) { const int tp_ = (jt) * 64 + lrow; if (tp_ >= PADR) { float* o_ = (ptr) + (size_t)tp_ * 512 + lch * 8; const u32x4 q_ = (VV); \
            *(f32x4*)o_ = (f32x4){bflo(q_.x), bfhi(q_.x), bflo(q_.y), bfhi(q_.y)}; *(f32x4*)(o_ + 4) = (f32x4){bflo(q_.z), bfhi(q_.z), bflo(q_.w), bfhi(q_.w)}; } } } while (0)
#define A_STOREK(S, b) do { LAS unsigned char* kb_ = KB + (b) * KBYTES; *(LAS u32x4*)(kb_ + lrow * KP + lch * 16) = S##k1; \
        if (DK == 96 && tid < 256) *(LAS u32x4*)(kb_ + (tid >> 2) * KP + 128 + (tid & 3) * 16) = S##k2; \
        if (FOX && tid < 64) { const unsigned w0_ = pk2(S##fb, 0.f) & 0xffffu; const float e1_ = S##fb - __uint_as_float(w0_ << 16); const unsigned w1_ = pk2(e1_, 0.f) & 0xffffu; const float e2_ = e1_ - __uint_as_float(w1_ << 16); \
            *(LAS u32x4*)(kb_ + tid * KP + 128) = (u32x4){w0_ | (w1_ << 16), pk2(e2_, 0.f) & 0xffffu, 0u, 0u}; } } while (0)
#define A_STOREV(S, b) do { *(LAS u32x4*)(VB + (b) * VBYTES + lrow * VP + lch * 16) = S##v; } while (0)
#define A_ITER(jt, L, S, PAR) do { const int jt_ = (jt); \
        { const int lk_ = jt_ + 2 < P.ntiles ? jt_ + 2 : P.ntiles - 1, lv_ = jt_ + 1 < P.ntiles ? jt_ + 1 : P.ntiles - 1; A_LOADK(a, lk_); A_LOADV(a, lv_); } \
        const bool mv_ = jt_ + 1 < P.ntiles; \
        const bool do_next = active && mv_ && jt_ + 1 <= last_tile, do_cur = active && jt_ <= last_tile; \
        const int kvbase = jt_ * 64; const bool needmask = (kvbase < mxl) || (kvbase + 63 > mnh); \
        if (active && jt_ <= last_tile) attn_fused<DK, FOX, (1 - PAR) * KBYTES, PAR * VBYTES>(kl, vl, qf, p0, p1, pn0, pn1, o0, o1, m_ref, l_run, jt_ == 0, kvbase, needmask, lo_l, hi_l, lane); \
        if (jt_ + 2 < P.ntiles) { A_STOREK(a, PAR); A_OUT8(P.okp, ak1, jt_ + 2); } \
        if (mv_) { A_STOREV(a, 1 - PAR); A_OUT8(P.ovp, av, jt_ + 1); } \
        asm volatile("s_waitcnt lgkmcnt(0)" ::: "memory"); __builtin_amdgcn_s_barrier(); asm volatile("" ::: "memory");     \
        p0 = pn0; p1 = pn1; } while (0)
    A_LOADK(a, 0); A_LOADV(a, 0); A_STOREK(a, 0); A_STOREV(a, 0); A_OUT8(P.okp, ak1, 0); A_OUT8(P.ovp, av, 0);
    if (P.ntiles > 1) { A_LOADK(a, 1); A_STOREK(a, 1); A_OUT8(P.okp, ak1, 1); }
    __syncthreads();
    if (active) attn_qk<DK, FOX, 0>(kl, qf, p0, p1, lane);
    __syncthreads();
    for (int jt = 0; jt < P.ntiles; jt += 2) {
        A_ITER(jt, a, b, 0);
        if (jt + 1 < P.ntiles) A_ITER(jt + 1, b, a, 1);
    }
#undef A_ITER
#undef A_LOADK
#undef A_LOADV
#undef A_STOREK
#undef A_STOREV
#undef A_OUT8
    float l; { const auto rr = __builtin_amdgcn_permlane32_swap(__float_as_uint(l_run), __float_as_uint(l_run), false, false); l = __uint_as_float(rr[0]) + __uint_as_float(rr[1]); }
    const float rl = 1.f / l;
    if (active && 32 * wid + r < P.nq) { bf16* op = P.O + (size_t)(32 * wid + r) * P.opitch + 4 * h;
#pragma unroll
        for (int g = 0; g < 4; ++g) {
            *(u32x2*)(op + 8 * g) = (u32x2){pk2(o0[4 * g] * rl, o0[4 * g + 1] * rl), pk2(o0[4 * g + 2] * rl, o0[4 * g + 3] * rl)};
            *(u32x2*)(op + 32 + 8 * g) = (u32x2){pk2(o1[4 * g] * rl, o1[4 * g + 1] * rl), pk2(o1[4 * g + 2] * rl, o1[4 * g + 3] * rl)}; } }
}
__device__ __forceinline__ void p4_attention(const KArgs& a, LAS unsigned char* lds, int vcu, int G) {
    unsigned char* ws = a.ws; const bf16* FQ = (const bf16*)(ws + W_FQ); bf16* OF = (bf16*)(ws + W_OCAT); const bf16* FK = (const bf16*)(ws + W_FK); const bf16* FV = (const bf16*)(ws + W_FV); const float* FB = (const float*)(ws + W_FB);
    const bf16* QM = (const bf16*)(ws + W_QMLA); const bf16* KV = (const bf16*)a.out; const bf16* KR = (const bf16*)(ws + W_KR); bf16* OM = (bf16*)(ws + W_OCAT) + 512;
    const float slf = 0.125f * LOG2E, slm = 0.10206207261596575f * LOG2E;
    for (int c = vcu; c < 256; c += G) { const int b = c >> 3, h = c & 7; const size_t r0 = (size_t)b * LP;
        for (int blk = 8; blk >= 0; --blk) { const int q0 = blk == 0 ? 0 : 64 + 256 * (blk - 1), nq = blk == 0 ? 64 : 256, nt = 4 * blk + 1;
            { AttnP P; P.Q = FQ + (r0 + q0) * 512 + h * 64; P.K1 = FK + r0 * 512 + h * 64; P.K2 = nullptr; P.V = FV + r0 * 512 + h * 64; P.FB = FB + (size_t)h * ER + r0; P.O = OF + (r0 + q0) * 1024 + h * 64; P.okp = blk == 8 ? a.out + O_KP + ((long)b * LSEQ - PADR) * 512 + h * 64 : nullptr; P.ovp = blk == 8 ? a.out + O_VP + ((long)b * LSEQ - PADR) * 512 + h * 64 : nullptr;
                P.qpitch = 512; P.k1pitch = 512; P.vpitch = 512; P.opitch = 1024; P.ntiles = nt; P.q0 = q0; P.nq = nq; P.cmode = 1; P.kvlo = PADR; P.qlo = PADR; P.kvhi = LP; P.sl2 = slf;
                attn_unit<64, true>(lds, P); }
            { AttnP P; P.Q = QM + (r0 + q0) * 768 + h * 96; P.K1 = KV + r0 * 1024 + h * 128; P.K2 = KR + r0 * 32; P.V = KV + r0 * 1024 + h * 128 + 64; P.FB = nullptr; P.okp = nullptr; P.ovp = nullptr; P.O = OM + (r0 + q0) * 1024 + h * 64;
                P.qpitch = 768; P.k1pitch = 1024; P.vpitch = 1024; P.opitch = 1024; P.ntiles = nt; P.q0 = q0; P.nq = nq; P.cmode = 2; P.kvlo = PADR; P.qlo = PADR; P.kvhi = LP; P.sl2 = slm;
                attn_unit<96, false>(lds, P); } }
        { const int typ = c >> 7, sb = (c & 127) >> 3; const size_t e0 = (size_t)MP + (size_t)sb * SXR, t0 = (size_t)MP + (size_t)sb * SN;
            if (typ == 0) { AttnP P; P.Q = FQ + t0 * 512 + h * 64; P.K1 = FK + e0 * 512 + h * 64; P.K2 = nullptr; P.V = FV + e0 * 512 + h * 64; P.FB = FB + (size_t)h * ER + e0; P.okp = nullptr; P.ovp = nullptr; P.O = OF + t0 * 1024 + h * 64;
                P.qpitch = 512; P.k1pitch = 512; P.vpitch = 512; P.opitch = 1024; P.ntiles = 17; P.q0 = PAST; P.nq = SN; P.cmode = 1; P.kvlo = 0; P.qlo = 0; P.kvhi = PAST + SN; P.sl2 = slf;
                attn_unit<64, true>(lds, P); }
            else { AttnP P; P.Q = QM + t0 * 768 + h * 96; P.K1 = KV + e0 * 1024 + h * 128; P.K2 = KR + e0 * 32; P.V = KV + e0 * 1024 + h * 128 + 64; P.FB = nullptr; P.okp = nullptr; P.ovp = nullptr; P.O = OM + t0 * 1024 + h * 64;
                P.qpitch = 768; P.k1pitch = 1024; P.vpitch = 1024; P.opitch = 1024; P.ntiles = 17; P.q0 = PAST; P.nq = SN; P.cmode = 0; P.kvlo = 0; P.qlo = 0; P.kvhi = PAST + SN; P.sl2 = slm;
                attn_unit<96, false>(lds, P); } }
    }
}

__device__ __forceinline__ void stagger(int bx, int step_ticks) {
    const unsigned long long t0 = __builtin_amdgcn_s_memrealtime(); const unsigned long long w = (unsigned long long)(((bx >> 3) & 7) * step_ticks);
    while (__builtin_amdgcn_s_memrealtime() - t0 < w) __builtin_amdgcn_s_sleep(16);
}
#ifndef STAG
#define STAG 0
#endif
#ifndef REP_P1
#define REP_P1 1
#endif
#ifndef REP_P4
#define REP_P4 1
#endif
#ifndef REP_P7
#define REP_P7 1
#endif
#define XB_TMO      128
#define XB_XCNT(j)  (256  + 64 * (j))
#define XB_XSUB(j)  (1280 + 64 * (j))
#define XB_XGEN(j)  (2304 + 64 * (j))
#define XB_TOP      3328
#define XB_TOPGEN   3392
#define XCD_BAR_WORDS 3456
#define XB_SPIN_CAP (1u << 18)

__device__ __forceinline__ unsigned xb_ld(unsigned* p)              { return __hip_atomic_load(p, __ATOMIC_RELAXED, __HIP_MEMORY_SCOPE_AGENT); }
__device__ __forceinline__ unsigned xb_add(unsigned* p, unsigned v) { return __hip_atomic_fetch_add(p, v, __ATOMIC_RELAXED, __HIP_MEMORY_SCOPE_AGENT); }
__device__ __forceinline__ unsigned xb_xcc_id() { return (unsigned)__builtin_amdgcn_s_getreg((3 << 11) | 20) & 0xFu; }
#define XB_SPIN(cond, bar) do { unsigned _sp = 0; while (cond) { __builtin_amdgcn_s_sleep(1); \
    if ((++_sp & 255u) == 0u) { if (xb_ld(&(bar)[XB_TMO])) break; if (_sp > XB_SPIN_CAP) { atomicAdd(&(bar)[XB_TMO], 1u); break; } } } } while (0)

struct XcdBarrier {
    unsigned* bar; unsigned x;
    volatile LAS unsigned* st;
};

__device__ __forceinline__ XcdBarrier xcd_barrier_post(unsigned* bar, volatile LAS unsigned* st) {
    XcdBarrier b; b.bar = bar; b.x = xb_xcc_id(); b.st = st;
    if (threadIdx.x == 0) (void)xb_add(&bar[XB_XCNT(b.x)], 1u);
    return b;
}
__device__ __forceinline__ void xcd_barrier_complete(unsigned* bar, unsigned x, unsigned& nloc, unsigned& nx) {
    const unsigned G = gridDim.x * gridDim.y * gridDim.z;
    unsigned sum, cnt, mine, sp = 0u;
    for (;;) {
        sum = 0u; cnt = 0u; mine = 0u;
#pragma unroll
        for (unsigned j = 0; j < 16; ++j) { const unsigned c = xb_ld(&bar[XB_XCNT(j)]); sum += c; cnt += (c > 0u) ? 1u : 0u; mine = (j == x) ? c : mine; }
        if (sum == G) break;
        __builtin_amdgcn_s_sleep(1);
        if ((++sp & 255u) == 0u) { if (xb_ld(&bar[XB_TMO])) break; if (sp > XB_SPIN_CAP) { atomicAdd(&bar[XB_TMO], 1u); break; } }
    }
    nloc = mine > 0u ? mine : 1u; nx = cnt > 0u ? cnt : 1u;
}

__device__ __forceinline__ void xcd_barrier(const XcdBarrier& b) {
    asm volatile("s_waitcnt vmcnt(0)" ::: "memory");
    __syncthreads();
    if (threadIdx.x == 0) {
        unsigned* bar = b.bar;
        __builtin_amdgcn_s_waitcnt(0);
        unsigned nloc = b.st[0], nx = b.st[1];
        if (nloc == 0u) { xcd_barrier_complete(bar, b.x, nloc, nx); b.st[0] = nloc; b.st[1] = nx; }
        const unsigned old = xb_add(&bar[XB_XSUB(b.x)], 1u);
        const unsigned gen = old / nloc;
        if (old + 1u == (gen + 1u) * nloc) {
            __builtin_amdgcn_fence(__ATOMIC_RELEASE, "agent");
            asm volatile("s_waitcnt vmcnt(0)" ::: "memory");
            const unsigned og = xb_add(&bar[XB_TOP], 1u);
            const unsigned tg = og / nx;
            if (og + 1u == (tg + 1u) * nx) xb_add(&bar[XB_TOPGEN], 1u);
            else XB_SPIN(xb_ld(&bar[XB_TOPGEN]) == tg, bar);
            __builtin_amdgcn_fence(__ATOMIC_ACQUIRE, "agent");
            xb_add(&bar[XB_XGEN(b.x)], 1u);
            asm volatile("s_waitcnt vmcnt(0)" ::: "memory");
        } else {
            XB_SPIN(xb_ld(&bar[XB_XGEN(b.x)]) == gen, bar);
            __builtin_amdgcn_fence(__ATOMIC_ACQUIRE, "agent");
            asm volatile("s_waitcnt vmcnt(0)" ::: "memory");
        }
    }
    __syncthreads();
}

constexpr int LDS_BYTES = 147456;
typedef const __attribute__((address_space(4))) KArgs* kargs_cptr;
#if defined(__HIP_DEVICE_COMPILE__)
__device__ __forceinline__ KArgs load_args() { auto p = __builtin_amdgcn_kernarg_segment_ptr(); asm volatile("" : "+s"(p)); const kargs_cptr q = (kargs_cptr)p; KArgs r;
#pragma unroll
    for (int i = 0; i < 25; ++i) r.in[i] = q->in[i];
    r.out = q->out; r.ws = q->ws; return r; }
#else
__device__ __forceinline__ KArgs load_args() { return KArgs{}; }
#endif
#define LANEVARS int t_ = threadIdx.x; asm volatile("" : "+v"(t_)); const int lane = t_ & 63, wave = __builtin_amdgcn_readfirstlane(t_ >> 6), gw = vcu * 8 + wave, gtid = bx * 512 + t_; (void)gtid; (void)lane; (void)gw
#define PHASE_BEGIN const KArgs a = load_args(); unsigned char* ws = a.ws; (void)ws; const int G = gridDim.x, bx = blockIdx.x, vcu = (G % 8 == 0) ? (bx % 8) * (G / 8) + bx / 8 : bx, NGW = G * 8, NT = G * 512; (void)NGW; (void)NT; (void)vcu; const pg8::AMap nat{0, 0, 256}; (void)nat
#define SEAM() do { __syncthreads(); grid.sync(); } while (0)
#define SEAMX() xcd_barrier(xbar)
__global__ void __launch_bounds__(512, 2) mega_fwd(KArgs a_in) {
    extern __shared__ __attribute__((aligned(16))) unsigned char lds_raw[];
    cg::grid_group grid = cg::this_grid();
    LAS unsigned char* lds = (LAS unsigned char*)lds_raw;
    (void)a_in;
    volatile LAS unsigned* xst = (volatile LAS unsigned*)(lds + 131072 + 1024);
    if (threadIdx.x < 2) xst[threadIdx.x] = 0u;
    __syncthreads();
    const XcdBarrier xbar = xcd_barrier_post((unsigned*)(load_args().ws + W_BAR), xst);
    { PHASE_BEGIN; LANEVARS; p0_prologue(a, lds, gw, NGW, wave, lane, gtid, NT); }
    SEAM();
    for (int rep_ = 0; rep_ < REP_P1; ++rep_) { PHASE_BEGIN;
        pg8::Gemm g{(const bf16*)(ws + W_XN), (const bf16*)(ws + W_WIN), MT, INWP, D}; pg8::StaticOrder S; S.init(MT, INWP, G, bx);
        pg8::EpiWin E{(bf16*)(ws + W_FQ), (bf16*)(ws + W_FK), (bf16*)(ws + W_FV), (bf16*)(ws + W_GATES), a.out, (bf16*)(ws + W_CQ), (float*)(ws + W_SSQ), (bf16*)(ws + W_CKVN), (bf16*)(ws + W_KR), (float*)(ws + W_LOGF), (const float*)(ws + W_ROPE), a.in[14], a.in[11], (LAS float*)(lds + 131072 + 4096)};
        pg8::gemm_phase<pg8::EpiWin, pg8::StaticOrder, true, true>(lds, g, S, E, nat); }
    SEAMX();
    { PHASE_BEGIN; LANEVARS; p3_scan(a, gw, NGW, lane); }
    { PHASE_BEGIN; pg8::Gemm g{(const bf16*)(ws + W_CQ), (const bf16*)(ws + W_WUQ), MT, 768, 384}; pg8::StaticOrder S; S.init(MT, 768, G, bx);
        pg8::EpiQ E{(bf16*)(ws + W_QMLA), (const float*)(ws + W_ROPE), (const float*)(ws + W_SSQ)};
        pg8::gemm_phase<pg8::EpiQ, pg8::StaticOrder, true, true>(lds, g, S, E, nat); }
    { PHASE_BEGIN; pg8::Gemm g{(const bf16*)(ws + W_CKVN), (const bf16*)(ws + W_WUKV), ER, 1024, 256}; pg8::StaticOrder S; S.init(ER, 1024, G, bx);
        pg8::EpiPlain E{(bf16*)a.out, 1024};
        pg8::gemm_phase<pg8::EpiPlain, pg8::StaticOrder, true, true>(lds, g, S, E, nat); }
    SEAMX();
    { PHASE_BEGIN; p4_attention(a, lds, vcu, G); }
#if REP_P4 > 1
    SEAMX();
    { PHASE_BEGIN; p4_attention(a, lds, vcu, G); }
#endif
    SEAMX();
    { PHASE_BEGIN; pg8::Gemm g{(const bf16*)(ws + W_OCAT), (const bf16*)(ws + W_WOC), MT, D, 1024}; pg8::StaticOrder S; S.init(MT, D, G, bx);
        pg8::EpiMixCat E{(bf16*)(ws + W_MIX), (const unsigned char*)(ws + W_GATES)};
        pg8::gemm_phase<pg8::EpiMixCat, pg8::StaticOrder, true, true>(lds, g, S, E, nat); }
    SEAMX();
    { PHASE_BEGIN; pg8::Gemm g{(const bf16*)(ws + W_MIX), (const bf16*)(ws + W_WOUT), MT, D, D}; pg8::StaticOrder S; S.init(MT, D, G, bx);
        pg8::EpiH1 E{a.in[0], a.in[8], a.in[1], (float*)(ws + W_H1), (bf16*)(ws + W_H1B), (float*)(ws + W_SS2)};
        pg8::gemm_phase<pg8::EpiH1, pg8::StaticOrder, true, true>(lds, g, S, E, nat); }
    SEAMX();
    for (int rep_ = 0; rep_ < REP_P7; ++rep_) {
    { PHASE_BEGIN; pg8::Gemm g{(const bf16*)(ws + W_H1B), (const bf16*)(ws + W_WUP), 269 * 256, UPW, D}; pg8::StaticOrder S; S.init(269 * 256, UPW, G, bx);
        pg8::EpiConv<false> E{(bf16*)(ws + W_G), (const float*)(ws + W_SS2), a.in[21], a.in[22], a.in[7], a.out, 126};
        pg8::gemm_phase<pg8::EpiConv<false>, pg8::StaticOrder, true, true>(lds, g, S, E, pg8::AMap{1, 126, 252}); }
    { PHASE_BEGIN; pg8::Gemm g{(const bf16*)(ws + W_H1B) + (size_t)MP * D, (const bf16*)(ws + W_WUP), 256, UPW, D}; pg8::StaticOrder S; S.init(256, UPW, G, G - 1 - bx);
        pg8::EpiConv<true> E{(bf16*)(ws + W_G), (const float*)(ws + W_SS2), a.in[21], a.in[22], a.in[7], a.out, 128};
        pg8::gemm_phase<pg8::EpiConv<true>, pg8::StaticOrder, true, true>(lds, g, S, E, pg8::AMap{1, 128, 256}); }
    }
    SEAMX();
    { PHASE_BEGIN; pg8::Gemm g{(const bf16*)(ws + W_G), (const bf16*)(ws + W_WDN), MT, D, DFF}; pg8::StaticOrder S; S.init(MT, D, G, bx); S.lim = (S.nwg / G) * G;
        pg8::EpiH2 E{(bf16*)(ws + W_H1B), (float*)(ws + W_SS3)};
        pg8::gemm_phase<pg8::EpiH2, pg8::StaticOrder, true, true>(lds, g, S, E, nat); }
    SEAMX();
    { PHASE_BEGIN; pg8::Gemm g{(const bf16*)(ws + W_G), (const bf16*)(ws + W_WDN), MT, D, DFF}; pg8::StaticOrder S; S.init(MT, D, G, bx);
        const int lim = (S.nwg / G) * G, ntail = S.nwg - lim; S.c = lim + bx; S.G = 1 << 24;
        pg8::EpiH2 E{(bf16*)(ws + W_H1B), (float*)(ws + W_SS3)};
        pg8::gemm_phase<pg8::EpiH2, pg8::StaticOrder, true, true>(lds, g, S, E, nat);
        if (bx >= ntail) { LANEVARS; p9_final(a, (bx - ntail) * 8 + wave, (G - ntail) * 8, lane, G, 0); } }
    SEAMX();
    { PHASE_BEGIN; LANEVARS; p9_final(a, gw, NGW, lane, G, 1); }
}

extern "C" void kernel_launch(void* const* d_in, const int* in_sizes, int n_in, void* d_out, int out_size, void* d_ws, size_t ws_size, hipStream_t stream) {
    static int grid = 0;
    if (grid == 0) {
        if (n_in != 25 || (size_t)out_size != O_END || ws_size < W_END) { fprintf(stderr, "kernel_launch: unexpected sizes n_in %d out %d (want %zu) ws %zu (want %zu)\n", n_in, out_size, (size_t)O_END, ws_size, (size_t)W_END); grid = -1; return; }
        int dev = 0, cus = 0, per_cu = 0;
        hipGetDevice(&dev); hipDeviceGetAttribute(&cus, hipDeviceAttributeMultiprocessorCount, dev);
        hipFuncSetAttribute((const void*)mega_fwd, hipFuncAttributeMaxDynamicSharedMemorySize, LDS_BYTES);
        hipOccupancyMaxActiveBlocksPerMultiprocessor(&per_cu, (const void*)mega_fwd, 512, LDS_BYTES);
        (void)hipGetLastError();
        if (per_cu < 1) per_cu = 1;
        grid = cus;
        if (grid > 256) grid = 256;
    }
    if (grid < 0) return;
    if (hipMemsetAsync((char*)d_ws + W_BAR, 0, XCD_BAR_WORDS * 4, stream) != hipSuccess) { fprintf(stderr, "kernel_launch: hipMemsetAsync failed\n"); return; }
    KArgs a{};
    for (int i = 0; i < 25; ++i) a.in[i] = (const float*)d_in[i];
    a.out = (float*)d_out; a.ws = (unsigned char*)d_ws;
    void* args[] = {&a};
    hipError_t e = hipLaunchCooperativeKernel((const void*)mega_fwd, dim3(grid), dim3(512), args, LDS_BYTES, stream);
    if (e != hipSuccess) fprintf(stderr, "cooperative launch failed: %s (grid %d)\n", hipGetErrorString(e), grid);
}
```
